# Optimizing an MI355X kernel written in HIP

```python
import jax, jax.numpy as jnp
from jax import lax
import numpy as np

D_MODEL = 1024
BATCH = 16
SEQ = 2048
DEPTH = 4

A_HEADS = 4
A_DK = 128
A_DV = 128
A_KD = A_HEADS * A_DK
A_WIDTH = A_HEADS * A_DV
A_CHUNK = 64
B_Q_HEADS = 8
B_KV_HEADS = 2
B_HEAD_DIM = 64
B_WIDTH = B_Q_HEADS * B_HEAD_DIM
B_KV_WIDTH = B_KV_HEADS * B_HEAD_DIM
WINDOW = 128
ROPE_DIM = B_HEAD_DIM // 4
ROPE_THETA = 500000.0
AB_IN_WIDTH = 2 * A_KD + 2 * A_WIDTH + B_WIDTH + 2 * B_KV_WIDTH
AB_OUT_WIDTH = A_WIDTH + B_WIDTH
POOL_WINDOWS = (2, 4, 8, 16)
POOL_GROUPS = 4
POOL_GROUP = D_MODEL // POOL_GROUPS
D_FF = 2816
CONV_WIDTH = 3
N_EVEN = (DEPTH + 1) // 2
N_ODD = DEPTH // 2
ALPHA = (2.0 * DEPTH) ** 0.25
BETA = (8.0 * DEPTH) ** -0.25
LN_EPS = 1e-5
RMS_EPS = 1e-6

kernel_name = "hybrid_hgrn2_swa_pool_convffn_deepnorm"

F32 = jnp.float32


def _layer_norm(x, g, b):
    xf = x.astype(F32)
    mu = xf.mean(-1, keepdims=True)
    var = jnp.mean(jnp.square(xf - mu), -1, keepdims=True)
    return ((xf - mu) * lax.rsqrt(var + LN_EPS) * g + b).astype(x.dtype)


def _rope(x, cos, sin):
    half = ROPE_DIM // 2
    x1 = x[..., :half].astype(F32)
    x2 = x[..., half:ROPE_DIM].astype(F32)
    r1 = x1 * cos - x2 * sin
    r2 = x2 * cos + x1 * sin
    return jnp.concatenate([r1.astype(x.dtype), r2.astype(x.dtype), x[..., ROPE_DIM:]], -1)


def _hgrn2(q, fz, i, lb):
    Bn, T = q.shape[:2]
    fzf = fz.astype(F32)
    f = lb + (1.0 - lb) * jax.nn.sigmoid(fzf)
    logf = jnp.log(f)
    k = (1.0 - lb) * jax.nn.sigmoid(-fzf)
    nc = T // A_CHUNK

    def to_chunks(a):
        a = a.reshape(Bn, nc, A_CHUNK, A_HEADS, a.shape[-1])
        return a.transpose(1, 0, 3, 2, 4)

    qc, kc, vc, gc = (to_chunks(a) for a in (q.astype(F32), k, i.astype(F32), logf))
    causal = jnp.tril(jnp.ones((A_CHUNK, A_CHUNK), bool))[:, :, None]

    def step(S, inp):
        qb, kb, vb, gb = inp
        b = jnp.cumsum(gb, axis=2)
        o_inter = jnp.einsum('bhtk,bhkv->bhtv', qb * jnp.exp(b), S)
        diff = b[:, :, :, None, :] - b[:, :, None, :, :]
        decay = jnp.exp(jnp.where(causal, diff, -jnp.inf))
        att = jnp.einsum('bhtk,bhsk,bhtsk->bhts', qb, kb, decay)
        o = o_inter + jnp.einsum('bhts,bhsv->bhtv', att, vb)
        b_last = b[:, :, -1:, :]
        S = jnp.exp(b_last[:, :, 0])[..., None] * S + jnp.einsum(
            'bhsk,bhsv->bhkv', kb * jnp.exp(b_last - b), vb)
        return S, o

    S0 = jnp.zeros((Bn, A_HEADS, A_DK, A_DV), F32)
    _, o = lax.scan(step, S0, (qc, kc, vc, gc))
    return o.transpose(1, 0, 3, 2, 4).reshape(Bn, T, A_HEADS, A_DV)


def _swa(q, k, v, sinks):
    Bn, T = q.shape[:2]
    nb = T // WINDOW
    G = B_Q_HEADS // B_KV_HEADS
    qb = q.reshape(Bn, nb, WINDOW, B_KV_HEADS, G, B_HEAD_DIM)

    def band(a):
        a = a.reshape(Bn, nb, WINDOW, B_KV_HEADS, B_HEAD_DIM)
        prev = jnp.pad(a, ((0, 0), (1, 0), (0, 0), (0, 0), (0, 0)))[:, :-1]
        return jnp.concatenate([prev, a], axis=2)

    kb, vb = band(k), band(v)
    s = jnp.einsum('bnqhgd,bnkhd->bnhgqk', qb, kb).astype(F32) * (B_HEAD_DIM ** -0.5)
    qi = jnp.arange(WINDOW)[:, None] + WINDOW
    ki = jnp.arange(2 * WINDOW)[None, :]
    rel = qi - ki
    allowed = (rel >= 0) & (rel < WINDOW)
    blk = jnp.arange(nb)[:, None, None]
    valid = allowed[None] & ((blk > 0) | (ki[None] >= WINDOW))
    s = jnp.where(valid[None, :, None, None], s, -jnp.inf)
    sink = sinks.astype(F32).reshape(B_KV_HEADS, G)[None, None, :, :, None, None]
    m = jnp.maximum(s.max(-1, keepdims=True), sink)
    p = jnp.exp(s - m)
    p = p / (p.sum(-1, keepdims=True) + jnp.exp(sink - m))
    o = jnp.einsum('bnhgqk,bnkhd->bnqhgd', p.astype(v.dtype), vb)
    return o.reshape(Bn, T, B_WIDTH)


def _even_mixer(h, w_in, w_out, lb, norm_g, sinks, cos, sin):
    Bn, T, _ = h.shape
    z = h @ w_in
    widths = [A_KD, A_KD, A_WIDTH, A_WIDTH, B_WIDTH, B_KV_WIDTH, B_KV_WIDTH]
    idx = np.cumsum(widths)[:-1].tolist()
    aq, af, ai, ag, bq, bk, bv = jnp.split(z, idx, axis=-1)
    oa = _hgrn2(aq.reshape(Bn, T, A_HEADS, A_DK), af.reshape(Bn, T, A_HEADS, A_DK),
                ai.reshape(Bn, T, A_HEADS, A_DV), lb.reshape(A_HEADS, A_DK))
    oa = oa * lax.rsqrt(jnp.mean(oa * oa, -1, keepdims=True) + RMS_EPS) * norm_g
    oa = oa.reshape(Bn, T, A_WIDTH).astype(h.dtype) * jax.nn.silu(ag)
    q = _rope(bq.reshape(Bn, T, B_Q_HEADS, B_HEAD_DIM), cos, sin)
    k = _rope(bk.reshape(Bn, T, B_KV_HEADS, B_HEAD_DIM), cos, sin)
    v = bv.reshape(Bn, T, B_KV_HEADS, B_HEAD_DIM)
    ob = _swa(q, k, v, sinks).astype(h.dtype)
    return jnp.concatenate([oa, ob], axis=-1) @ w_out


def _pool_mixer(h, w_grp, scale):
    Bn, T, D = h.shape
    hf = h.astype(F32).reshape(Bn, T, POOL_GROUPS, POOL_GROUP)
    t = jnp.arange(T)
    outs = []
    for gi, w in enumerate(POOL_WINDOWS):
        xg = hf[:, :, gi]
        cs = jnp.cumsum(jnp.pad(xg, ((0, 0), (w, 0), (0, 0))), axis=1)
        win_sum = cs[:, w:] - cs[:, :T]
        cnt = jnp.minimum(t + 1, w).astype(F32)[None, :, None]
        outs.append(win_sum / cnt - xg)
    pooled = jnp.stack(outs, axis=2).astype(h.dtype)
    y = jnp.einsum('btgc,gcd->btgd', pooled, w_grp)
    return y.reshape(Bn, T, D) * scale


def _conv_ffn(h, w_up, conv_w, conv_b, w_down):
    T = h.shape[1]
    u, v = jnp.split(h @ w_up, 2, axis=-1)
    up = jnp.pad(u, ((0, 0), (CONV_WIDTH - 1, 0), (0, 0)))
    uc = conv_b
    for j in range(CONV_WIDTH):
        uc = uc + up[:, j:j + T] * conv_w[j]
    return (jax.nn.silu(uc) * v) @ w_down


def setup_inputs(seed: int = 0) -> dict:
    key = jax.random.key(seed)
    ks = jax.random.split(key, 20)
    n = jax.random.normal
    D = D_MODEL
    x = n(ks[0], (BATCH, SEQ, D), F32)
    c = n(ks[1], (BATCH, D), F32)
    offs = jax.random.randint(ks[2], (BATCH, 1), 0, 4096, dtype=jnp.int32)
    positions = offs + jnp.arange(SEQ, dtype=jnp.int32)[None, :]
    ada_w = n(ks[3], (DEPTH, D, 6 * D), F32) * D ** -0.5
    ada_b = 0.02 * n(ks[4], (DEPTH, 6 * D), F32)
    ln_g = 1.0 + 0.02 * n(ks[5], (DEPTH, 2, D), F32)
    ln_b = 0.02 * n(ks[6], (DEPTH, 2, D), F32)
    ab_w_in = n(ks[7], (N_EVEN, D, AB_IN_WIDTH), F32) * D ** -0.5
    ab_w_out = n(ks[8], (N_EVEN, AB_OUT_WIDTH, D), F32) * (AB_OUT_WIDTH ** -0.5 * BETA)
    hgrn_lb_raw = 0.5 * n(ks[9], (N_EVEN, A_KD), F32)
    hgrn_norm_g = 1.0 + 0.02 * n(ks[10], (N_EVEN, A_DV), F32)
    attn_sinks = 0.5 * n(ks[11], (N_EVEN, B_Q_HEADS), F32)
    pool_w = n(ks[12], (N_ODD, POOL_GROUPS, POOL_GROUP, POOL_GROUP), F32) * (POOL_GROUP ** -0.5 * BETA)
    pool_scale = 1.0 + 0.02 * n(ks[13], (N_ODD, D), F32)
    ffn_w_up = n(ks[14], (DEPTH, D, 2 * D_FF), F32) * D ** -0.5
    ffn_conv_w = n(ks[15], (DEPTH, CONV_WIDTH, D_FF), F32) * CONV_WIDTH ** -0.5
    ffn_conv_b = 0.02 * n(ks[16], (DEPTH, D_FF), F32)
    ffn_w_down = n(ks[17], (DEPTH, D_FF, D), F32) * (D_FF ** -0.5 * BETA)
    return {"x": x, "c": c, "positions": positions, "ada_w": ada_w, "ada_b": ada_b,
            "ln_g": ln_g, "ln_b": ln_b, "ab_w_in": ab_w_in, "ab_w_out": ab_w_out,
            "hgrn_lb_raw": hgrn_lb_raw, "hgrn_norm_g": hgrn_norm_g, "attn_sinks": attn_sinks,
            "pool_w": pool_w, "pool_scale": pool_scale, "ffn_w_up": ffn_w_up,
            "ffn_conv_w": ffn_conv_w, "ffn_conv_b": ffn_conv_b, "ffn_w_down": ffn_w_down}


def reference(x, c, positions, ada_w, ada_b, ln_g, ln_b, ab_w_in, ab_w_out,
              hgrn_lb_raw, hgrn_norm_g, attn_sinks, pool_w, pool_scale,
              ffn_w_up, ffn_conv_w, ffn_conv_b, ffn_w_down):
    lb_p = jax.nn.softmax(hgrn_lb_raw.astype(F32), axis=0)
    lower_bounds = jnp.cumsum(lb_p, axis=0) - lb_p[0]
    inv_freq = ROPE_THETA ** (-jnp.arange(0, ROPE_DIM, 2, dtype=F32) / ROPE_DIM)
    ang = positions.astype(F32)[..., None] * inv_freq
    cos = jnp.cos(ang)[:, :, None, :]
    sin = jnp.sin(ang)[:, :, None, :]
    c_act = jax.nn.silu(c)
    for l in range(DEPTH):
        mod = c_act @ ada_w[l] + ada_b[l]
        sh1, sc1, g1, sh2, sc2, g2 = [m[:, None, :] for m in jnp.split(mod, 6, axis=-1)]
        h = x * (1.0 + sc1) + sh1
        if l % 2 == 0:
            e = l // 2
            y = _even_mixer(h, ab_w_in[e], ab_w_out[e], lower_bounds[e], hgrn_norm_g[e],
                            attn_sinks[e], cos, sin)
        else:
            o = l // 2
            y = _pool_mixer(h, pool_w[o], pool_scale[o])
        x = _layer_norm(ALPHA * x + g1 * y, ln_g[l, 0], ln_b[l, 0])
        h = x * (1.0 + sc2) + sh2
        y = _conv_ffn(h, ffn_w_up[l], ffn_conv_w[l], ffn_conv_b[l], ffn_w_down[l])
        x = _layer_norm(ALPHA * x + g2 * y, ln_g[l, 1], ln_b[l, 1])
    return x
```

```cpp
#include <hip/hip_runtime.h>
#include <hip/hip_cooperative_groups.h>
#include <cstdio>
namespace cg = cooperative_groups;

#ifndef MEGA
#define MEGA 1
#endif

#define LAS __attribute__((address_space(3)))
typedef unsigned short bf16_t;
typedef short bf16x8 __attribute__((ext_vector_type(8)));
typedef float f32x4 __attribute__((ext_vector_type(4)));
typedef unsigned u32x4 __attribute__((ext_vector_type(4)));
typedef unsigned u32x2 __attribute__((ext_vector_type(2)));

constexpr int MTOK = 32768, DM = 1024, SEQ_T = 2048, NB = 16;
constexpr int ZW = 2816, FF = 2816;
constexpr float ALPHA_C = 1.681792830507429f;
constexpr int LDS_BYTES = 163840;
#define XB_TMO      128
#define XCD_BAR_WORDS 3456
constexpr int BAR_TOTAL_WORDS = XCD_BAR_WORDS + 128 * 64;

struct Params {
    const float* x_in; const float* c; const int* pos; const float* ada_w; const float* ada_b;
    const float* ln_g; const float* ln_b; const float* w_in; const float* w_out; const float* lb_raw;
    const float* norm_g; const float* sinks; const float* pool_w; const float* pool_scale;
    const float* w_up; const float* conv_w; const float* conv_b; const float* w_down;
    float* out;
    bf16_t* wt_in; bf16_t* wt_out; bf16_t* wt_up; bf16_t* wt_down; bf16_t* wt_pool;
    float* mod; float* rope; bf16_t* h; bf16_t* za; float* L; float* dec; float* side; unsigned* bar; unsigned* xbuf;
};


constexpr int PARAM_OFF = LDS_BYTES - 512;
__device__ __forceinline__ unsigned long long ldq(const unsigned* lp, int idx) {
    const unsigned lo = __builtin_amdgcn_readfirstlane(lp[2 * idx]), hi = __builtin_amdgcn_readfirstlane(lp[2 * idx + 1]);
    return ((unsigned long long)hi << 32) | lo;
}
__device__ __forceinline__ Params load_params(const unsigned char* smem) {
    const unsigned* lp = (const unsigned*)(smem + PARAM_OFF);
    Params p;
    p.x_in = (decltype(p.x_in))ldq(lp, 0);
    p.c = (decltype(p.c))ldq(lp, 1);
    p.pos = (decltype(p.pos))ldq(lp, 2);
    p.ada_w = (decltype(p.ada_w))ldq(lp, 3);
    p.ada_b = (decltype(p.ada_b))ldq(lp, 4);
    p.ln_g = (decltype(p.ln_g))ldq(lp, 5);
    p.ln_b = (decltype(p.ln_b))ldq(lp, 6);
    p.w_in = (decltype(p.w_in))ldq(lp, 7);
    p.w_out = (decltype(p.w_out))ldq(lp, 8);
    p.lb_raw = (decltype(p.lb_raw))ldq(lp, 9);
    p.norm_g = (decltype(p.norm_g))ldq(lp, 10);
    p.sinks = (decltype(p.sinks))ldq(lp, 11);
    p.pool_w = (decltype(p.pool_w))ldq(lp, 12);
    p.pool_scale = (decltype(p.pool_scale))ldq(lp, 13);
    p.w_up = (decltype(p.w_up))ldq(lp, 14);
    p.conv_w = (decltype(p.conv_w))ldq(lp, 15);
    p.conv_b = (decltype(p.conv_b))ldq(lp, 16);
    p.w_down = (decltype(p.w_down))ldq(lp, 17);
    p.out = (decltype(p.out))ldq(lp, 18);
    p.wt_in = (decltype(p.wt_in))ldq(lp, 19);
    p.wt_out = (decltype(p.wt_out))ldq(lp, 20);
    p.wt_up = (decltype(p.wt_up))ldq(lp, 21);
    p.wt_down = (decltype(p.wt_down))ldq(lp, 22);
    p.wt_pool = (decltype(p.wt_pool))ldq(lp, 23);
    p.mod = (decltype(p.mod))ldq(lp, 24);
    p.rope = (decltype(p.rope))ldq(lp, 25);
    p.h = (decltype(p.h))ldq(lp, 26);
    p.za = (decltype(p.za))ldq(lp, 27);
    p.L = (decltype(p.L))ldq(lp, 28);
    p.dec = (decltype(p.dec))ldq(lp, 29);
    p.side = (decltype(p.side))ldq(lp, 30);
    return p;
}


__device__ __forceinline__ int otid() { int t = (int)threadIdx.x; asm volatile("" : "+v"(t)); return t; }
__device__ __forceinline__ int obid() { int b = (int)blockIdx.x; asm volatile("" : "+s"(b)); return b; }
__device__ __forceinline__ int ogrid() { int g = (int)gridDim.x; asm volatile("" : "+s"(g)); return g; }
__device__ __forceinline__ float bf2f(bf16_t v) { return __uint_as_float(((unsigned)v) << 16); }
__device__ __forceinline__ unsigned pk2(float lo, float hi) { unsigned r; asm volatile("v_cvt_pk_bf16_f32 %0, %1, %2" : "=v"(r) : "v"(lo), "v"(hi)); return r; }
__device__ __forceinline__ bf16_t f2bf(float f) { return (bf16_t)(pk2(f, 0.f) & 0xffffu); }
__device__ __forceinline__ float fast_sigmoid(float x) { return __builtin_amdgcn_rcpf(1.0f + __expf(-x)); }
__device__ __forceinline__ float silu_f(float x) { return x * fast_sigmoid(x); }
__device__ __forceinline__ f32x4 mfma16(bf16x8 a, bf16x8 b, f32x4 c) { return __builtin_amdgcn_mfma_f32_16x16x32_bf16(a, b, c, 0, 0, 0); }
__device__ __forceinline__ float wave_sum(float v) {
#pragma unroll
    for (int o = 32; o >= 1; o >>= 1) v += __shfl_xor(v, o);
    return v;
}

namespace pg8 {
constexpr int BM = 256, BK = 64, HALF = 128, HTB = HALF * BK * 2, STAGE_BYTES = 8 * HTB, NXCD = 8, WGM = 8;
__host__ __device__ __forceinline__ int lds_byte(int r, int c) { const int st = (r >> 4) * 2 + (c >> 5), rr = r & 15, cc = c & 31, ob = rr * 64 + cc * 2; return st * 1024 + (ob ^ (((ob >> 9) & 1) << 5)); }
__host__ __device__ __forceinline__ void stage_rc(int b, int& R, int& C) { const int st = b / 1024, sb = b % 1024, swz = sb ^ (((sb >> 9) & 1) << 5); R = (st >> 1) * 16 + swz / 64; C = (st & 1) * 32 + (swz % 64) / 2; }
__host__ __device__ __forceinline__ int perm32(int rho) { const int n = rho >> 4, i = rho & 15; return 8 * (i >> 2) + 4 * n + (i & 3); }

struct Unit { int pm, pn; };
struct Gemm { const bf16_t* A; const bf16_t* Bt; int M, N, K; };

struct StaticOrder {
    int nM, nN, nwg, G, c;
    __device__ void init(int M, int N, int G_, int c_) { nM = M / BM; nN = N / BM; nwg = nM * nN; G = G_; c = c_; }
    __device__ bool next(int i, Unit& u) const {
        const long L = (long)i * G + c; if (L >= nwg) return false;
        int wgid = (int)L; { const int q = nwg / NXCD, r = nwg % NXCD, xcd = wgid % NXCD, off = wgid / NXCD; wgid = (xcd < r ? xcd * (q + 1) : r * (q + 1) + (xcd - r) * q) + off; }
        const int nig = WGM * nN, gid = wgid / nig, fm = gid * WGM, gsz = (nM - fm) < WGM ? (nM - fm) : WGM;
        u.pm = fm + ((wgid % nig) % gsz); u.pn = (wgid % nig) / gsz; return true;
    }
    __device__ __forceinline__ void a_ready(const Unit&) const {}
    __device__ __forceinline__ void done(const Unit&) const {}
};
struct PoolOrder {
    int G, c;
    __device__ bool next(int i, Unit& u) const { const int L = i * G + c; if (L >= 512) return false; u.pm = L; u.pn = L >> 7; return true; }
    __device__ __forceinline__ void a_ready(const Unit&) const {}
    __device__ __forceinline__ void done(const Unit&) const {}
};

struct PassOrder {
    StaticOrder S; int pass;
    __device__ bool next(int i, Unit& u) const { return i == 0 ? S.next(pass, u) : false; }
    __device__ __forceinline__ void a_ready(const Unit&) const {}
    __device__ __forceinline__ void done(const Unit&) const {}
};
struct PoolPassOrder {
    int G, c, pass;
    __device__ bool next(int i, Unit& u) const { if (i > 0) return false; const int L = pass * G + c; if (L >= 512) return false; const int g = L & 3, rt = L >> 2; u.pm = g * 128 + rt; u.pn = g; return true; }
    __device__ __forceinline__ void a_ready(const Unit&) const {}
    __device__ __forceinline__ void done(const Unit&) const {}
};

template <class Epi, class Sched>
__device__ __forceinline__ void gemm_phase(LAS unsigned char* lds, const Gemm g, const Sched& S, const Epi& E) {
    const int tid = otid(), wid = __builtin_amdgcn_readfirstlane(tid >> 6), lane = tid & 63, wr = wid >> 2, wc = wid & 3, fr = lane & 15, fq = lane >> 4;
    const int K = g.K, nt = K / BK;
    unsigned voffA[2], voffB[2];
#pragma unroll
    for (int i = 0; i < 2; ++i) { int R, C; stage_rc(tid * 16 + i * 8192, R, C); const int Rb = Epi::PERM ? ((R & ~31) + perm32(R & 31)) : R;
        voffA[i] = (unsigned)(R * K + C) * 2u; voffB[i] = (unsigned)(Rb * K + C) * 2u; }
    const size_t kstep = (size_t)(BK * 2);
    const size_t hstep = (size_t)HALF * K * 2;
    const size_t tstep = 2 * hstep;
    const unsigned ldsw = (unsigned)wid * 1024u;
    const int aoff = lds_byte(wr * 64 + fr, fq * 8), boff = lds_byte(wc * 32 + fr, fq * 8);
#define PG8_SA(b, h) (((b) * 2 + (h)) * HTB)
#define PG8_SB(b, h) ((4 + (b) * 2 + (h)) * HTB)
#define PG8_STAGE(bufoff, gbase, voff) do { _Pragma("unroll") for (int _i = 0; _i < 2; ++_i) \
        __builtin_amdgcn_global_load_lds((const unsigned*)((const char*)(gbase) + (voff)[_i]), (LAS unsigned*)(lds + (bufoff) + ldsw + _i * 8192), 16, 0, 0); } while (0)
#define PG8_LDA(dst, b, h) do { _Pragma("unroll") for (int m = 0; m < 4; ++m) _Pragma("unroll") for (int k = 0; k < 2; ++k) dst[m][k] = *(const LAS bf16x8*)(lds + PG8_SA(b, h) + aoff + m * 2048 + k * 1024); } while (0)
#define PG8_LDB(dst, b, h) do { _Pragma("unroll") for (int n = 0; n < 2; ++n) _Pragma("unroll") for (int k = 0; k < 2; ++k) dst[n][k] = *(const LAS bf16x8*)(lds + PG8_SB(b, h) + boff + n * 2048 + k * 1024); } while (0)
#define PG8_MMA(ai, bj, At, Bt) do { __builtin_amdgcn_s_setprio(1); _Pragma("unroll") for (int m = 0; m < 4; ++m) _Pragma("unroll") for (int n = 0; n < 2; ++n) _Pragma("unroll") for (int k = 0; k < 2; ++k) \
        acc[ai][bj][m][n] = __builtin_amdgcn_mfma_f32_16x16x32_bf16(Bt[n][k], At[m][k], acc[ai][bj][m][n], 0, 0, 0); __builtin_amdgcn_s_setprio(0); } while (0)
#define PG8_WAIT_V(n) asm volatile("s_waitcnt vmcnt(" #n ")" ::: "memory")
#define PG8_WAIT_L(n) asm volatile("s_waitcnt lgkmcnt(" #n ")" ::: "memory")
#define PG8_BAR __builtin_amdgcn_s_barrier()
#define PG8_SCHED __builtin_amdgcn_sched_barrier(0)
    Unit cur, nxt; int ui = 0;
    if (!S.next(0, cur)) return;
    f32x4 acc[2][2][4][2];
#pragma unroll
    for (int a = 0; a < 2; ++a)
#pragma unroll
        for (int b = 0; b < 2; ++b)
#pragma unroll
            for (int m = 0; m < 4; ++m)
#pragma unroll
                for (int n = 0; n < 2; ++n) acc[a][b][m][n] = (f32x4){0.f, 0.f, 0.f, 0.f};
    bf16x8 At[4][2], B0[2][2], B1[2][2];
    const char* cA = (const char*)g.A + (size_t)cur.pm * tstep; const char* cB = (const char*)g.Bt + (size_t)cur.pn * tstep;
    S.a_ready(cur);
    if constexpr (Epi::PREFETCH) E.prefetch(cur, 0, lds, wid, lane);
    PG8_STAGE(PG8_SB(0, 0), cB, voffB); PG8_STAGE(PG8_SA(0, 0), cA, voffA); PG8_STAGE(PG8_SB(0, 1), cB + hstep, voffB); PG8_STAGE(PG8_SA(0, 1), cA + hstep, voffA);
    if (wr == 1) PG8_BAR;
    PG8_WAIT_V(4); PG8_BAR;
    PG8_STAGE(PG8_SB(1, 0), cB + kstep, voffB); PG8_STAGE(PG8_SA(1, 0), cA + kstep, voffA); PG8_STAGE(PG8_SB(1, 1), cB + hstep + kstep, voffB);
    PG8_WAIT_V(6); PG8_BAR;
    for (;;) {
        const bool has_next = S.next(ui + 1, nxt);
        const char* nA = has_next ? (const char*)g.A + (size_t)nxt.pm * tstep : cA; const char* nB = has_next ? (const char*)g.Bt + (size_t)nxt.pn * tstep : cB;
        for (int t = 0; t < nt; t += 2) {
            const bool last = (t == nt - 2);
            const char* a1 = cA + (size_t)(t + 1) * kstep;
            const char* a2 = last ? nA : cA + (size_t)(t + 2) * kstep; const char* b2 = last ? nB : cB + (size_t)(t + 2) * kstep;
            const char* a3 = a2 + kstep; const char* b3 = b2 + kstep;
            if (last && has_next) S.a_ready(nxt);
            PG8_LDB(B0, 0, 0); PG8_SCHED; PG8_LDA(At, 0, 0); PG8_STAGE(PG8_SA(1, 1), a1 + hstep, voffA);
            PG8_WAIT_L(8); PG8_BAR; PG8_WAIT_L(0); PG8_MMA(0, 0, At, B0); PG8_BAR; PG8_SCHED;
            PG8_LDB(B1, 0, 1); PG8_STAGE(PG8_SB(0, 0), b2, voffB);
            PG8_BAR; PG8_WAIT_L(0); PG8_MMA(0, 1, At, B1); PG8_BAR;
            PG8_LDA(At, 0, 1); PG8_STAGE(PG8_SA(0, 0), a2, voffA);
            PG8_BAR; PG8_WAIT_L(0); PG8_MMA(1, 0, At, B0); PG8_BAR; PG8_SCHED;
            PG8_STAGE(PG8_SB(0, 1), b2 + hstep, voffB);
            PG8_WAIT_V(6); PG8_BAR; PG8_MMA(1, 1, At, B1); PG8_BAR;
            PG8_LDB(B0, 1, 0); PG8_SCHED; PG8_LDA(At, 1, 0); PG8_STAGE(PG8_SA(0, 1), a2 + hstep, voffA);
            PG8_WAIT_L(8); PG8_BAR; PG8_WAIT_L(0); PG8_MMA(0, 0, At, B0); PG8_BAR; PG8_SCHED;
            PG8_LDB(B1, 1, 1); PG8_STAGE(PG8_SB(1, 0), b3, voffB);
            PG8_BAR; PG8_WAIT_L(0); PG8_MMA(0, 1, At, B1); PG8_BAR;
            PG8_LDA(At, 1, 1); PG8_STAGE(PG8_SA(1, 0), a3, voffA);
            PG8_BAR; PG8_WAIT_L(0); PG8_MMA(1, 0, At, B0); PG8_BAR; PG8_SCHED;
            PG8_STAGE(PG8_SB(1, 1), b3 + hstep, voffB);
            PG8_WAIT_V(6); PG8_BAR; PG8_MMA(1, 1, At, B1); PG8_BAR;
        }
        if constexpr (Epi::PREFETCH) { E.run(acc, cur, ui, lds, wr, wc, fr, fq); if (has_next) E.prefetch(nxt, ui + 1, lds, wid, lane); }
        else if constexpr (!Epi::AFTER_DRAIN) E(acc, cur, wr, wc, fr, fq);
        if (!has_next) break;
#pragma unroll
        for (int a = 0; a < 2; ++a)
#pragma unroll
            for (int b = 0; b < 2; ++b)
#pragma unroll
                for (int m = 0; m < 4; ++m)
#pragma unroll
                    for (int n = 0; n < 2; ++n) acc[a][b][m][n] = (f32x4){0.f, 0.f, 0.f, 0.f};
        cur = nxt; cA = nA; cB = nB; ++ui;
    }
    PG8_WAIT_V(0);
    if (wr == 0) PG8_BAR;
    PG8_BAR;
    if constexpr (Epi::AFTER_DRAIN) E.fused(acc, cur, wr, wc, fr, fq, lds, wid, lane);
#undef PG8_SA
#undef PG8_SB
#undef PG8_STAGE
#undef PG8_LDA
#undef PG8_LDB
#undef PG8_MMA
#undef PG8_WAIT_V
#undef PG8_WAIT_L
#undef PG8_BAR
#undef PG8_SCHED
}
}

struct EpiStoreBf16 {
    static constexpr bool PERM = true, AFTER_DRAIN = false, PREFETCH = false;
    bf16_t* O; int ldc;
    __device__ __forceinline__ void operator()(const f32x4 (&acc)[2][2][4][2], const pg8::Unit& u, int wr, int wc, int fr, int fq) const {
        const int row0 = u.pm * 256 + wr * 64 + fr, col0 = u.pn * 256 + wc * 32 + 8 * fq;
#pragma unroll
        for (int ai = 0; ai < 2; ++ai)
#pragma unroll
            for (int m = 0; m < 4; ++m) {
                bf16_t* rowp = O + (size_t)(row0 + ai * 128 + m * 16) * ldc + col0;
#pragma unroll
                for (int bj = 0; bj < 2; ++bj) {
                    const f32x4 v0 = acc[ai][bj][m][0], v1 = acc[ai][bj][m][1];
                    u32x4 o; o[0] = pk2(v0[0], v0[1]); o[1] = pk2(v0[2], v0[3]); o[2] = pk2(v1[0], v1[1]); o[3] = pk2(v1[2], v1[3]);
                    *(u32x4*)(rowp + bj * 128) = o;
                }
            }
    }
};
struct LnFuse {
    const float* xin; float* xout; const float* gate; const float* lng; const float* lnb;
    const float* msc; const float* msh; bf16_t* hout;
    unsigned long long* xbuf; unsigned* cnt; unsigned* tmo; unsigned want;
};
__device__ __forceinline__ float ror8f(float v) { return __int_as_float(__builtin_amdgcn_update_dpp(0, __float_as_int(v), 0x128, 0xf, 0xf, false)); }
__device__ __forceinline__ unsigned ror8u(unsigned v) { return (unsigned)__builtin_amdgcn_update_dpp(0, (int)v, 0x128, 0xf, 0xf, false); }
__device__ __forceinline__ f32x4 ror8v(f32x4 v) { return (f32x4){ror8f(v[0]), ror8f(v[1]), ror8f(v[2]), ror8f(v[3])}; }
template <bool GROUPED> struct EpiResidLn {
    static constexpr bool PERM = true, AFTER_DRAIN = true, PREFETCH = false;
    LnFuse f;
    typedef float f32x2v __attribute__((ext_vector_type(2)));
    __device__ __forceinline__ void half_load(f32x4 (&xi)[4][2][2], int ai, int rowb0, int col0, int fr) const {
        const int hi = fr >> 3, r8 = fr & 7;
#pragma unroll
        for (int m = 0; m < 4; ++m) {
            const float* xr = f.xin + (size_t)(rowb0 + ai * 128 + m * 16 + r8) * 1024 + col0 + 4 * hi;
#pragma unroll
            for (int bj = 0; bj < 2; ++bj) { xi[m][bj][0] = *(const f32x4*)(xr + bj * 128); xi[m][bj][1] = *(const f32x4*)(xr + 8 * 1024 + bj * 128); }
        }
    }
    __device__ __forceinline__ void half_v(f32x4 (&h)[2][4][2], const f32x4 (&xi)[4][2][2], const f32x4 (&gv)[2][2], int fr) const {
        const bool hi = (fr >> 3) != 0;
#pragma unroll
        for (int m = 0; m < 4; ++m)
#pragma unroll
            for (int bj = 0; bj < 2; ++bj) {
                const f32x4 i1 = xi[m][bj][0], i2 = xi[m][bj][1];
                const f32x4 recv = ror8v(hi ? i1 : i2);
                const f32x4 x0 = hi ? recv : i1, x1 = hi ? i2 : recv;
                h[bj][m][0] = x0 * ALPHA_C + gv[bj][0] * h[bj][m][0];
                h[bj][m][1] = x1 * ALPHA_C + gv[bj][1] * h[bj][m][1];
            }
    }
    __device__ __forceinline__ void half_stats(const f32x4 (&h)[2][4][2], int ai, int wr, int wc, int fr, int fq, LAS f32x2v* P) const {
#pragma unroll
        for (int m = 0; m < 4; ++m) {
            float sm = 0.f;
#pragma unroll
            for (int bj = 0; bj < 2; ++bj)
#pragma unroll
                for (int n = 0; n < 2; ++n) { const f32x4 x = h[bj][m][n]; sm += (x[0] + x[1]) + (x[2] + x[3]); }
            sm += __shfl_xor(sm, 16); sm += __shfl_xor(sm, 32);
            const float mw = sm * (1.0f / 64.0f); float q = 0.f;
#pragma unroll
            for (int bj = 0; bj < 2; ++bj)
#pragma unroll
                for (int n = 0; n < 2; ++n) { const f32x4 d = h[bj][m][n] - mw; q += (d[0] * d[0] + d[1] * d[1]) + (d[2] * d[2] + d[3] * d[3]); }
            q += __shfl_xor(q, 16); q += __shfl_xor(q, 32);
            if (fq == 0) P[(ai * 128 + wr * 64 + m * 16 + fr) * 4 + wc] = (f32x2v){mw, q};
        }
    }
    struct ColPar { f32x4 gg[2][2], bb[2][2], sc[2][2], sh[2][2]; };
    __device__ __forceinline__ void half5(const f32x4 (&h)[2][4][2], const ColPar& cp, bool has_h, int ai, int rt, int col0, int wr, int fr, const LAS f32x2v* S) const {
        const bool hi = (fr >> 3) != 0; const int r8 = fr & 7, c4 = hi ? 4 : 0;
#pragma unroll
        for (int m = 0; m < 4; ++m) {
            const int r = ai * 128 + wr * 64 + m * 16 + fr; const f32x2v sr = S[r];
            const size_t off1 = (size_t)(rt * 256 + ai * 128 + wr * 64 + m * 16 + r8) * 1024 + col0 + c4;
#pragma unroll
            for (int bj = 0; bj < 2; ++bj) {
                const f32x4 y0 = (h[bj][m][0] - sr.x) * sr.y * cp.gg[bj][0] + cp.bb[bj][0];
                const f32x4 y1 = (h[bj][m][1] - sr.x) * sr.y * cp.gg[bj][1] + cp.bb[bj][1];
                const f32x4 recv = ror8v(hi ? y0 : y1);
                *(f32x4*)(f.xout + off1 + bj * 128) = hi ? recv : y0;
                *(f32x4*)(f.xout + off1 + 8 * 1024 + bj * 128) = hi ? y1 : recv;
                if (has_h) {
                    const f32x4 h0 = y0 * (cp.sc[bj][0] + 1.0f) + cp.sh[bj][0], h1 = y1 * (cp.sc[bj][1] + 1.0f) + cp.sh[bj][1];
                    u32x2 p0, p1; p0[0] = pk2(h0[0], h0[1]); p0[1] = pk2(h0[2], h0[3]); p1[0] = pk2(h1[0], h1[1]); p1[1] = pk2(h1[2], h1[3]);
                    u32x2 snd = hi ? p0 : p1, rcv; rcv[0] = ror8u(snd[0]); rcv[1] = ror8u(snd[1]);
                    *(u32x2*)(f.hout + off1 + bj * 128) = hi ? rcv : p0;
                    *(u32x2*)(f.hout + off1 + 8 * 1024 + bj * 128) = hi ? p1 : rcv;
                }
                asm volatile("" ::: "memory"); __builtin_amdgcn_sched_barrier(0);
            }
        }
    }
    __device__ __forceinline__ void fused(f32x4 (&acc)[2][2][4][2], const pg8::Unit& u, int wr, int wc, int fr_, int fq_, LAS unsigned char* lds, int wid, int lane_) const {
        int lane = lane_; asm volatile("" : "+v"(lane));
        const int fr = lane & 15, fq = lane >> 4; (void)fr_; (void)fq_;
        const int rt = GROUPED ? (u.pm & 127) : u.pm, ct = GROUPED ? (u.pm >> 7) : u.pn;
        const int b = rt >> 3;
        const int rowb0 = rt * 256 + wr * 64, col0 = ct * 256 + wc * 32 + 8 * fq;
        LAS unsigned char* RA = lds + (wid * 64 + lane) * 16;
        LAS f32x2v* P = (LAS f32x2v*)(lds + 131072);
        LAS f32x2v* S = (LAS f32x2v*)(lds + 139264);
        f32x4 h[2][4][2], xi[4][2][2];
        half_load(xi, 0, rowb0, col0, fr);
        f32x4 gv[2][2];
        { const float* gp = f.gate + (size_t)b * 6144 + col0;
#pragma unroll
          for (int bj = 0; bj < 2; ++bj)
#pragma unroll
              for (int n = 0; n < 2; ++n) gv[bj][n] = *(const f32x4*)(gp + bj * 128 + n * 4); }
#pragma unroll
        for (int bj = 0; bj < 2; ++bj)
#pragma unroll
            for (int m = 0; m < 4; ++m)
#pragma unroll
                for (int n = 0; n < 2; ++n) { *(LAS f32x4*)(RA + ((bj * 4 + m) * 2 + n) * 8192) = acc[1][bj][m][n]; h[bj][m][n] = acc[0][bj][m][n]; }
        asm volatile("" ::: "memory");
        half_v(h, xi, gv, fr);
        asm volatile("" ::: "memory");
        half_load(xi, 1, rowb0, col0, fr);
        half_stats(h, 0, wr, wc, fr, fq, P);
#pragma unroll
        for (int bj = 0; bj < 2; ++bj)
#pragma unroll
            for (int m = 0; m < 4; ++m)
#pragma unroll
                for (int n = 0; n < 2; ++n) { LAS f32x4* sp = (LAS f32x4*)(RA + ((bj * 4 + m) * 2 + n) * 8192); const f32x4 t = *sp; *sp = h[bj][m][n]; h[bj][m][n] = t; }
        asm volatile("" ::: "memory");
        half_v(h, xi, gv, fr);
        half_stats(h, 1, wr, wc, fr, fq, P);
        ColPar cp; const bool has_h = f.msc != nullptr;
        {
            const float* mscp = has_h ? f.msc + (size_t)b * 6144 + col0 : f.lng + col0;
            const float* mshp = has_h ? f.msh + (size_t)b * 6144 + col0 : f.lng + col0;
#pragma unroll
            for (int bj = 0; bj < 2; ++bj)
#pragma unroll
                for (int n = 0; n < 2; ++n) { const int co = bj * 128 + n * 4;
                    cp.gg[bj][n] = *(const f32x4*)(f.lng + col0 + co); cp.bb[bj][n] = *(const f32x4*)(f.lnb + col0 + co);
                    cp.sc[bj][n] = *(const f32x4*)(mscp + co); cp.sh[bj][n] = *(const f32x4*)(mshp + co); }
        }
        asm volatile("s_waitcnt lgkmcnt(0)" ::: "memory"); __builtin_amdgcn_s_barrier(); asm volatile("" ::: "memory");
        const int row = wid * 32 + (lane & 31);
        if (lane < 32) {
            const f32x2v a = P[row * 4 + 0], bq = P[row * 4 + 1], c = P[row * 4 + 2], d = P[row * 4 + 3];
            const float mt = (a.x + bq.x + c.x + d.x) * 0.25f;
            const float da = a.x - mt, db = bq.x - mt, dc = c.x - mt, dd = d.x - mt;
            const float m2 = (a.y + bq.y) + (c.y + d.y) + 64.0f * ((da * da + db * db) + (dc * dc + dd * dd));
            unsigned long long* slot = f.xbuf + ((size_t)(rt * 256 + row) * 4 + ct);
            __hip_atomic_store(slot, ((unsigned long long)__float_as_uint(m2) << 32) | __float_as_uint(mt), __ATOMIC_RELAXED, __HIP_MEMORY_SCOPE_AGENT);
        }
        asm volatile("s_waitcnt vmcnt(0)" ::: "memory");
        if (lane == 0) __hip_atomic_fetch_add(f.cnt + 64 * rt, 1u, __ATOMIC_RELAXED, __HIP_MEMORY_SCOPE_AGENT);
        if (wid == 0) {
            unsigned sp = 0u;
            while ((unsigned)__builtin_amdgcn_readfirstlane(__hip_atomic_load(f.cnt + 64 * rt, __ATOMIC_RELAXED, __HIP_MEMORY_SCOPE_AGENT)) < f.want) {
                __builtin_amdgcn_s_sleep(2);
                if (++sp > (1u << 22)) { if (lane == 0) __hip_atomic_store(f.tmo, 1u, __ATOMIC_RELAXED, __HIP_MEMORY_SCOPE_AGENT); break; }
            }
            __builtin_amdgcn_fence(__ATOMIC_ACQUIRE, "agent");
        }
        asm volatile("s_waitcnt vmcnt(0) lgkmcnt(0)" ::: "memory"); __builtin_amdgcn_s_barrier(); asm volatile("" ::: "memory");
        if (lane < 32) {
            const unsigned long long* slot = f.xbuf + (size_t)(rt * 256 + row) * 4; float mt[4], m2[4]; float ms = 0.f;
#pragma unroll
            for (int t = 0; t < 4; ++t) { const unsigned long long w = __hip_atomic_load(slot + t, __ATOMIC_RELAXED, __HIP_MEMORY_SCOPE_AGENT); mt[t] = __uint_as_float((unsigned)w); m2[t] = __uint_as_float((unsigned)(w >> 32)); ms += mt[t]; }
            const float mean = ms * 0.25f; float q = 0.f;
#pragma unroll
            for (int t = 0; t < 4; ++t) { const float dm = mt[t] - mean; q += m2[t] + 256.0f * dm * dm; }
            S[row] = (f32x2v){mean, 1.0f / sqrtf(q * (1.0f / 1024.0f) + 1e-5f)};
        }
        asm volatile("s_waitcnt lgkmcnt(0)" ::: "memory"); __builtin_amdgcn_s_barrier(); asm volatile("" ::: "memory");
        int lane5 = lane; asm volatile("" : "+v"(lane5));
        const int fr5 = lane5 & 15, col5 = ct * 256 + wc * 32 + 8 * (lane5 >> 4);
        half5(h, cp, has_h, 1, rt, col5, wr, fr5, S);
        asm volatile("" ::: "memory");
#pragma unroll
        for (int bj = 0; bj < 2; ++bj)
#pragma unroll
            for (int m = 0; m < 4; ++m)
#pragma unroll
                for (int n = 0; n < 2; ++n) h[bj][m][n] = *(const LAS f32x4*)(RA + ((bj * 4 + m) * 2 + n) * 8192);
        asm volatile("" ::: "memory");
        half5(h, cp, has_h, 0, rt, col5, wr, fr5, S);
        asm volatile("s_waitcnt lgkmcnt(0)" ::: "memory"); __builtin_amdgcn_s_barrier(); asm volatile("" ::: "memory");
    }
};
struct EpiConvGate {
    static constexpr bool PERM = true, AFTER_DRAIN = false, PREFETCH = true;
    bf16_t* a; float* side; const float* cw; const float* cb;
    static constexpr int PAR_OFF = 131072;
    __device__ __forceinline__ void prefetch(const pg8::Unit& u, int ui, LAS unsigned char* lds, int wid, int lane) const {
        if (wid == 0) {
            const int fcol = u.pn * 128 + (lane & 31) * 4, hi = lane >> 5;
            const float* s0 = (hi ? cw + 2816 : cw) + fcol;
            const float* s1 = (hi ? cb : cw + 5632) + fcol;
            LAS unsigned char* dst = lds + PAR_OFF + (ui & 1) * 2048;
            __builtin_amdgcn_global_load_lds((const unsigned*)s0, (LAS unsigned*)dst, 16, 0, 0);
            __builtin_amdgcn_global_load_lds((const unsigned*)s1, (LAS unsigned*)(dst + 1024), 16, 0, 0);
        }
    }
    __device__ __forceinline__ void run(const f32x4 (&acc)[2][2][4][2], const pg8::Unit& u, int ui, LAS unsigned char* lds, int wr, int wc, int fr, int fq) const {
        const LAS float* par = (const LAS float*)(lds + PAR_OFF + (ui & 1) * 2048);
        const int lane = fr + 16 * fq;
        const int src1 = (lane & 48) | ((fr + 15) & 15), src2 = (lane & 48) | ((fr + 14) & 15);
        const int f0 = u.pn * 128 + wc * 32 + 8 * fq;
#pragma unroll
        for (int n = 0; n < 2; ++n) {
            const int fb = f0 + 4 * n;
            const int fl = wc * 32 + 8 * fq + 4 * n;
            const f32x4 w0 = *(const LAS f32x4*)(par + fl), w1 = *(const LAS f32x4*)(par + 128 + fl), w2 = *(const LAS f32x4*)(par + 256 + fl), bb = *(const LAS f32x4*)(par + 384 + fl);
#pragma unroll
            for (int ai = 0; ai < 2; ++ai) {
                const int strip = u.pm * 4 + ai * 2 + wr;
                float* sd = side + (size_t)strip * (6 * 2816) + fb;
                if (fr < 2) { *(f32x4*)(sd + fr * 2816) = acc[ai][0][0][n]; *(f32x4*)(sd + (2 + fr) * 2816) = acc[ai][1][0][n]; }
                if (fr >= 14) { *(f32x4*)(sd + (4 + fr - 14) * 2816) = acc[ai][0][3][n]; }
                f32x4 s1p = (f32x4){0.f, 0.f, 0.f, 0.f}, s2p = s1p;
#pragma unroll
                for (int m = 0; m < 4; ++m) {
                    const f32x4 uu = acc[ai][0][m][n];
                    f32x4 s1, s2;
#pragma unroll
                    for (int e = 0; e < 4; ++e) { s1[e] = __shfl(uu[e], src1); s2[e] = __shfl(uu[e], src2); }
                    const f32x4 p1 = fr >= 1 ? s1 : s1p, p2 = fr >= 2 ? s2 : s2p;
                    const f32x4 uc = bb + w0 * p2 + w1 * p1 + w2 * uu;
                    const f32x4 vv = acc[ai][1][m][n];
                    f32x4 r;
#pragma unroll
                    for (int e = 0; e < 4; ++e) r[e] = silu_f(uc[e]) * vv[e];
                    s1p = s1; s2p = s2;
                    if (!(m == 0 && fr < 2)) {
                        u32x2 o; o[0] = pk2(r[0], r[1]); o[1] = pk2(r[2], r[3]);
                        *(u32x2*)(a + (size_t)(u.pm * 256 + ai * 128 + wr * 64 + m * 16 + fr) * FF + fb) = o;
                    }
                }
            }
        }
    }
};

struct TrDesc { const float* src; bf16_t* dst; const float* scale; int ldS, K, k0, n0, col0; };
__device__ __forceinline__ TrDesc tr_decode(const Params& p, int t) {
    TrDesc d; d.scale = nullptr;
    if (t < 704) { const int e = t / 352, r = t % 352, kt = r / 22, nt = r % 22;
        d.src = p.w_in + (size_t)e * 1024 * 2816; d.ldS = 2816; d.K = 1024; d.dst = p.wt_in + (size_t)e * 2816 * 1024; d.k0 = kt * 64; d.n0 = nt * 128; d.col0 = nt * 128; }
    else if (t < 960) { const int tt = t - 704, e = tt / 128, r = tt % 128, kt = r / 8, nt = r % 8;
        d.src = p.w_out + (size_t)e * 1024 * 1024; d.ldS = 1024; d.K = 1024; d.dst = p.wt_out + (size_t)e * 1024 * 1024; d.k0 = kt * 64; d.n0 = nt * 128; d.col0 = nt * 128; }
    else if (t < 3776) { const int tt = t - 960, l = tt / 704, r = tt % 704, kt = r / 44, nt = r % 44;
        const int j0 = nt * 128, pn = j0 >> 8, half = (j0 >> 7) & 1;
        d.src = p.w_up + (size_t)l * 1024 * 5632; d.ldS = 5632; d.K = 1024; d.dst = p.wt_up + (size_t)l * 5632 * 1024; d.k0 = kt * 64; d.n0 = j0; d.col0 = half * 2816 + pn * 128; }
    else if (t < 5184) { const int tt = t - 3776, l = tt / 352, r = tt % 352, kt = r / 8, nt = r % 8;
        d.src = p.w_down + (size_t)l * 2816 * 1024; d.ldS = 1024; d.K = 2816; d.dst = p.wt_down + (size_t)l * 1024 * 2816; d.k0 = kt * 64; d.n0 = nt * 128; d.col0 = nt * 128; }
    else { const int tt = t - 5184, og = tt / 8, r = tt % 8, kt = r / 2, nt = r % 2;
        d.src = p.pool_w + (size_t)og * 65536; d.ldS = 256; d.K = 256; d.dst = p.wt_pool + (size_t)og * 65536; d.k0 = kt * 64; d.n0 = nt * 128; d.col0 = nt * 128;
        d.scale = p.pool_scale + (og >> 2) * 1024 + (og & 3) * 256; }
    return d;
}
__device__ __forceinline__ void tr_load(const TrDesc& d, int tid, f32x4 (&v)[4]) {
    const int r = tid >> 5, c4 = (tid & 31) * 4;
#pragma unroll
    for (int i = 0; i < 4; ++i) v[i] = *(const f32x4*)(d.src + (size_t)(d.k0 + r + 16 * i) * d.ldS + d.col0 + c4);
}
__device__ __forceinline__ void phase_prep(const Params& p, unsigned char* smem) {
    const int tid = otid(), lane = tid & 63, wid = tid >> 6;
    {
        float* cact = (float*)smem;
        float* red = cact + 16384;
        for (int i = tid; i < 16384; i += 512) { const float cv = p.c[i]; cact[i] = silu_f(cv); }
        __syncthreads();
        for (int tile = obid(); tile < 192; tile += ogrid()) {
            const int col = tile * 128 + lane, l = col / 6144, j = col % 6144;
            const float* w = p.ada_w + (size_t)l * 1024 * 6144 + j;
            const int k0 = wid * 128;
            float acc0[16], acc1[16];
#pragma unroll
            for (int b = 0; b < 16; ++b) { acc0[b] = 0.f; acc1[b] = 0.f; }
            for (int kk = 0; kk < 128; kk += 8) {
                float w0[8], w1[8];
#pragma unroll
                for (int q = 0; q < 8; ++q) { w0[q] = w[(size_t)(k0 + kk + q) * 6144]; w1[q] = w[(size_t)(k0 + kk + q) * 6144 + 64]; }
#pragma unroll
                for (int q4 = 0; q4 < 2; ++q4)
#pragma unroll
                    for (int b = 0; b < 16; ++b) { const f32x4 cv = *(const f32x4*)(cact + b * 1024 + k0 + kk + 4 * q4);
                        acc0[b] += cv[0] * w0[4 * q4] + cv[1] * w0[4 * q4 + 1] + cv[2] * w0[4 * q4 + 2] + cv[3] * w0[4 * q4 + 3];
                        acc1[b] += cv[0] * w1[4 * q4] + cv[1] * w1[4 * q4 + 1] + cv[2] * w1[4 * q4 + 2] + cv[3] * w1[4 * q4 + 3]; }
            }
#pragma unroll
            for (int b = 0; b < 16; ++b) { red[(wid * 16 + b) * 128 + lane] = acc0[b]; red[(wid * 16 + b) * 128 + 64 + lane] = acc1[b]; }
            __syncthreads();
#pragma unroll
            for (int i = 0; i < 4; ++i) { const int o = tid + 512 * i, b = o >> 7, cl = o & 127;
                float sm = 0.f;
#pragma unroll
                for (int w8 = 0; w8 < 8; ++w8) sm += red[(w8 * 16 + b) * 128 + cl];
                const int cc = tile * 128 + cl, ll = cc / 6144, jj = cc % 6144;
                p.mod[((size_t)ll * 16 + b) * 6144 + jj] = sm + p.ada_b[ll * 6144 + jj]; }
            __syncthreads();
        }
    }
    {
        float* tile = (float*)smem;
        const int gstep = ogrid();
        int t = obid();
        f32x4 v[4];
        TrDesc d = tr_decode(p, t < 5248 ? t : 0);
        if (t < 5248) tr_load(d, tid, v);
        for (; t < 5248; t += gstep) {
            { const int r = tid >> 5, c4 = (tid & 31) * 4;
#pragma unroll
              for (int i = 0; i < 4; ++i) { float* tp = tile + (r + 16 * i) * 129 + c4; tp[0] = v[i][0]; tp[1] = v[i][1]; tp[2] = v[i][2]; tp[3] = v[i][3]; } }
            __syncthreads();
            const TrDesc dc = d;
            if (t + gstep < 5248) { d = tr_decode(p, t + gstep); tr_load(d, tid, v); }
#pragma unroll
            for (int i = 0; i < 2; ++i) {
                const int o = tid + 512 * i, n = o >> 3, k8 = (o & 7) * 8; const float sc = dc.scale ? dc.scale[dc.n0 + n] : 1.0f;
                float w[8];
#pragma unroll
                for (int e2 = 0; e2 < 8; ++e2) w[e2] = tile[(k8 + e2) * 129 + n] * sc;
                u32x4 ov; ov[0] = pk2(w[0], w[1]); ov[1] = pk2(w[2], w[3]); ov[2] = pk2(w[4], w[5]); ov[3] = pk2(w[6], w[7]);
                if (dc.scale) {
                    const int dd = dc.n0 + n, kk = dc.k0 + k8;
                    *(u32x4*)(dc.dst + ((size_t)(((dd >> 4) * 8 + (kk >> 5)) * 64 + ((kk & 31) >> 3) * 16 + (dd & 15))) * 8) = ov;
                } else
                *(u32x4*)(dc.dst + (size_t)(dc.n0 + n) * dc.K + dc.k0 + k8) = ov;
            }
            __syncthreads();
        }
    }
    for (int idx = obid() * 512 + tid; idx < MTOK * 8; idx += ogrid() * 512) {
        const int row = idx >> 3, i = idx & 7;
        const float invf = i == 0 ? 1.0f : i == 1 ? 0.1939227432012558f : i == 2 ? 0.03760603070259094f : i == 3 ? 0.007292664609849453f
                         : i == 4 ? 0.0014142135623842478f : i == 5 ? 0.00027424818836152554f : i == 6 ? 5.3182957344688475e-05f : 1.0313385246263351e-05f;
        const float ang = (float)p.pos[row] * invf;
        const float nrev = rintf(ang * 0.15915494309189535f);
        float rr = fmaf(-nrev, 6.2831854820251465f, ang); rr = fmaf(-nrev, -1.7484556025237907e-07f, rr);
        p.rope[row * 16 + i] = __cosf(rr);
        p.rope[row * 16 + 8 + i] = __sinf(rr);
    }
}

__device__ __forceinline__ void phase_h0(const Params& p) {
    const int gt = obid() * 512 + otid(), gs = ogrid() * 512;
    for (int i0 = gt; i0 < MTOK * 256; i0 += 4 * gs) {
        f32x4 x[4];
#pragma unroll
        for (int j = 0; j < 4; ++j) { const int i4 = i0 + j * gs; if (i4 < MTOK * 256) x[j] = *(const f32x4*)(p.x_in + (size_t)i4 * 4); }
#pragma unroll
        for (int j = 0; j < 4; ++j) {
            const int i4 = i0 + j * gs;
            if (i4 < MTOK * 256) {
                const int row = i4 >> 8, col = (i4 & 255) * 4, b = row >> 11;
                const float* mp = p.mod + (size_t)b * 6144;
                const f32x4 sh = *(const f32x4*)(mp + col), sc = *(const f32x4*)(mp + 1024 + col);
                const f32x4 hh = x[j] * (sc + 1.0f) + sh;
                u32x2 o; o[0] = pk2(hh[0], hh[1]); o[1] = pk2(hh[2], hh[3]);
                *(u32x2*)(p.h + (size_t)i4 * 4) = o;
            }
        }
    }
}

__device__ __forceinline__ void phase_ln(const Params& p, int l, int sub) {
    const int lane = otid() & 63, wid = otid() >> 6;
    const float* g = p.ln_g + (l * 2 + sub) * 1024; const float* bt = p.ln_b + (l * 2 + sub) * 1024;
    const bool has_next = !(l == 3 && sub == 1);
    const int nl = sub == 0 ? l : l + 1, sc_off = sub == 0 ? 4096 : 1024, sh_off = sub == 0 ? 3072 : 0;
    for (int row = obid() * 8 + wid; row < MTOK; row += ogrid() * 8) {
        float* xr = p.out + (size_t)row * 1024;
        f32x4 v[4];
#pragma unroll
        for (int i = 0; i < 4; ++i) v[i] = *(const f32x4*)(xr + i * 256 + lane * 4);
        float s = 0.f;
#pragma unroll
        for (int i = 0; i < 4; ++i) s += v[i][0] + v[i][1] + v[i][2] + v[i][3];
        s = wave_sum(s); const float mu = s * (1.0f / 1024.0f);
        float q = 0.f;
#pragma unroll
        for (int i = 0; i < 4; ++i) { const f32x4 d = v[i] - mu; q += d[0] * d[0] + d[1] * d[1] + d[2] * d[2] + d[3] * d[3]; }
        q = wave_sum(q); const float rstd = rsqrtf(q * (1.0f / 1024.0f) + 1e-5f);
        const int b = row >> 11;
        const float* mp = p.mod + ((size_t)nl * 16 + b) * 6144;
#pragma unroll
        for (int i = 0; i < 4; ++i) {
            const int col = i * 256 + lane * 4;
            const f32x4 gg = *(const f32x4*)(g + col), bb = *(const f32x4*)(bt + col);
            const f32x4 y = (v[i] - mu) * rstd * gg + bb;
            *(f32x4*)(xr + col) = y;
            if (has_next) {
                const f32x4 sc = *(const f32x4*)(mp + sc_off + col), sh = *(const f32x4*)(mp + sh_off + col);
                const f32x4 hh = y * (sc + 1.0f) + sh;
                u32x2 o; o[0] = pk2(hh[0], hh[1]); o[1] = pk2(hh[2], hh[3]);
                *(u32x2*)(p.h + (size_t)row * 1024 + col) = o;
            }
        }
    }
}

__device__ __forceinline__ float lb_of(const Params& p, int e, int kidx) {
    if (e == 0) return 0.f;
    const float r0 = p.lb_raw[kidx], r1 = p.lb_raw[512 + kidx];
    return 1.0f / (1.0f + __expf(r0 - r1));
}

__device__ __forceinline__ void phase_hgrnA(const Params& p, int e, unsigned char* smem) {
    const int tid = otid(), k = tid & 127, seg = tid >> 7, lane = tid & 63, wid = tid >> 6, fr = lane & 15, fq = lane >> 4;
    float* segsum = (float*)smem;
    bf16_t* kT = (bf16_t*)(smem + 2048);
    bf16_t* vT = kT + 128 * 72;
    const int gstep = ogrid();
    float lb4[4];
#pragma unroll
    for (int q = 0; q < 4; ++q) lb4[q] = lb_of(p, e, q * 128 + k);
    unsigned fzr[16], vr[16];
    { const int item = obid();
      if (item < 2048) { const int c = item & 31, bh = item >> 5, hh = bh & 3, b = bh >> 2;
          const bf16_t* zf = p.za + ((size_t)b * 2048 + c * 64 + seg * 16) * ZW + 512 + hh * 128 + k;
#pragma unroll
          for (int i = 0; i < 16; ++i) { fzr[i] = zf[(size_t)i * ZW]; vr[i] = zf[(size_t)i * ZW + 512]; } } }
    for (int item = obid(); item < 2048; item += gstep) {
        const int c = item & 31, bh = item >> 5, hh = bh & 3, b = bh >> 2;
        const float lb = hh == 0 ? lb4[0] : hh == 1 ? lb4[1] : hh == 2 ? lb4[2] : lb4[3], oml = 1.0f - lb;
        float kk[16], bb[16]; float run = 0.f;
#pragma unroll
        for (int i = 0; i < 16; ++i) {
            float fz = __uint_as_float(fzr[i] << 16); fz = fminf(fmaxf(fz, -30.f), 30.f);
            const float em = __expf(-fz), sg = __builtin_amdgcn_rcpf(1.0f + em);
            run += __logf(lb + oml * sg); bb[i] = run; kk[i] = oml * em * sg;
        }
        unsigned vraw[8];
#pragma unroll
        for (int i = 0; i < 8; ++i) vraw[i] = vr[2 * i] | (vr[2 * i + 1] << 16);
        { const int nitem = item + gstep;
          if (nitem < 2048) { const int c2 = nitem & 31, bh2 = nitem >> 5, hh2 = bh2 & 3, b2 = bh2 >> 2;
              const bf16_t* zf = p.za + ((size_t)b2 * 2048 + c2 * 64 + seg * 16) * ZW + 512 + hh2 * 128 + k;
#pragma unroll
              for (int i = 0; i < 16; ++i) { fzr[i] = zf[(size_t)i * ZW]; vr[i] = zf[(size_t)i * ZW + 512]; } } }
        segsum[seg * 128 + k] = run;
        __syncthreads();
        float off = 0.f, tot = 0.f;
#pragma unroll
        for (int s = 0; s < 4; ++s) { const float v = segsum[s * 128 + k]; tot += v; if (s < seg) off += v; }
        unsigned kp[8];
#pragma unroll
        for (int i = 0; i < 8; ++i) kp[i] = pk2(kk[2 * i] * __expf(tot - off - bb[2 * i]), kk[2 * i + 1] * __expf(tot - off - bb[2 * i + 1]));
        *(u32x4*)(kT + k * 72 + seg * 16) = (u32x4){kp[0], kp[1], kp[2], kp[3]};
        *(u32x4*)(kT + k * 72 + seg * 16 + 8) = (u32x4){kp[4], kp[5], kp[6], kp[7]};
        *(u32x4*)(vT + k * 72 + seg * 16) = (u32x4){vraw[0], vraw[1], vraw[2], vraw[3]};
        *(u32x4*)(vT + k * 72 + seg * 16 + 8) = (u32x4){vraw[4], vraw[5], vraw[6], vraw[7]};
        if (seg == 0) p.dec[(size_t)item * 128 + k] = __expf(tot);
        __syncthreads();
        f32x4 acc[8];
#pragma unroll
        for (int n = 0; n < 8; ++n) acc[n] = (f32x4){0.f, 0.f, 0.f, 0.f};
#pragma unroll
        for (int ks = 0; ks < 2; ++ks) {
            const bf16x8 a = *(const bf16x8*)(kT + (16 * wid + fr) * 72 + ks * 32 + fq * 8);
#pragma unroll
            for (int n = 0; n < 8; ++n) { const bf16x8 bq = *(const bf16x8*)(vT + (16 * n + fr) * 72 + ks * 32 + fq * 8); acc[n] = mfma16(a, bq, acc[n]); }
        }
        bf16_t* Lp = (bf16_t*)p.L + (size_t)item * 16384;
#pragma unroll
        for (int n = 0; n < 8; ++n) { u32x2 o; o[0] = pk2(acc[n][0], acc[n][1]); o[1] = pk2(acc[n][2], acc[n][3]);
            *(u32x2*)(Lp + (16 * n + fr) * 128 + 16 * wid + 4 * fq) = o; }
        __syncthreads();
    }
}

__device__ __forceinline__ f32x4 bf4_to_f32(u32x2 w) { return (f32x4){__uint_as_float(w[0] << 16), __uint_as_float(w[0] & 0xffff0000u), __uint_as_float(w[1] << 16), __uint_as_float(w[1] & 0xffff0000u)}; }
__device__ __forceinline__ void phase_hgrnB(const Params& p) {
    const int gs = ogrid() * 512;
    for (int task = obid() * 512 + otid(); task < 64 * 4096; task += 2 * gs) {
        const int task2 = task + gs; const bool two = task2 < 64 * 4096;
        const int bh = task >> 12, e4 = task & 4095, bh2 = two ? (task2 >> 12) : bh, e42 = two ? (task2 & 4095) : e4;
        bf16_t* base = (bf16_t*)p.L + (size_t)bh * 32 * 16384 + e4 * 4;
        bf16_t* base2 = (bf16_t*)p.L + (size_t)bh2 * 32 * 16384 + e42 * 4;
        const float* d = p.dec + (size_t)bh * 32 * 128 + ((e4 * 4) & 127);
        const float* d2 = p.dec + (size_t)bh2 * 32 * 128 + ((e42 * 4) & 127);
        float zf = 0.f; asm volatile("" : "+v"(zf));
        f32x4 S = (f32x4){zf, zf, zf, zf}, S2 = S;
#pragma unroll
        for (int c0 = 0; c0 < 32; c0 += 8) {
            u32x2 tmp[8], tmp2[8]; f32x4 dd[8], dd2[8];
#pragma unroll
            for (int c = 0; c < 8; ++c) { tmp[c] = *(const u32x2*)(base + (size_t)(c0 + c) * 16384); tmp2[c] = *(const u32x2*)(base2 + (size_t)(c0 + c) * 16384);
                dd[c] = *(const f32x4*)(d + (c0 + c) * 128); dd2[c] = *(const f32x4*)(d2 + (c0 + c) * 128); }
#pragma unroll
            for (int c = 0; c < 8; ++c) {
                { u32x2 o; o[0] = pk2(S[0], S[1]); o[1] = pk2(S[2], S[3]); *(u32x2*)(base + (size_t)(c0 + c) * 16384) = o; }
                S = dd[c] * S + bf4_to_f32(tmp[c]);
                if (two) { u32x2 o; o[0] = pk2(S2[0], S2[1]); o[1] = pk2(S2[2], S2[3]); *(u32x2*)(base2 + (size_t)(c0 + c) * 16384) = o;
                    S2 = dd2[c] * S2 + bf4_to_f32(tmp2[c]); }
            }
        }
    }
}

__device__ __forceinline__ void phase_hgrnC(const Params& p, int e, unsigned char* smem) {
    const int tid = otid(), k = tid & 127, seg = tid >> 7, lane = tid & 63, wid = tid >> 6, fr = lane & 15, fq = lane >> 4;
    float* segsum = (float*)smem;
    float* ssq = (float*)(smem + 2048);
    bf16_t* Qe = (bf16_t*)(smem + 4096);
    bf16_t* Qi = Qe + 64 * 136;
    bf16_t* Sb = Qi + 64 * 136;
    bf16_t* Kh = Sb + 128 * 136;
    bf16_t* vT = Kh + 160 * 136;
    bf16_t* At = vT + 128 * 72;
    const int gstep = ogrid();
    float lb4[4];
#pragma unroll
    for (int q = 0; q < 4; ++q) lb4[q] = lb_of(p, e, q * 128 + k);
    f32x4 ng4[4];
#pragma unroll
    for (int n = 0; n < 4; ++n) ng4[n] = *(const f32x4*)(p.norm_g + e * 128 + 16 * ((wid & 1) * 4 + n) + 4 * fq);
    unsigned qr[16], fzr[16], vr[16];
    { const int item = obid();
      if (item < 2048) { const int c = item & 31, bh = item >> 5, hh = bh & 3, b = bh >> 2;
          const bf16_t* zq = p.za + ((size_t)b * 2048 + c * 64 + seg * 16) * ZW + hh * 128 + k;
#pragma unroll
          for (int i = 0; i < 16; ++i) { qr[i] = zq[(size_t)i * ZW]; fzr[i] = zq[(size_t)i * ZW + 512]; vr[i] = zq[(size_t)i * ZW + 1024]; } } }
    for (int item = obid(); item < 2048; item += gstep) {
        const int c = item & 31, bh = item >> 5, hh = bh & 3, b = bh >> 2;
        const size_t rowc = (size_t)b * 2048 + c * 64;
        const float lb = hh == 0 ? lb4[0] : hh == 1 ? lb4[1] : hh == 2 ? lb4[2] : lb4[3], oml = 1.0f - lb;
        float kk[16], bb[16], qq[16]; float run = 0.f;
#pragma unroll
        for (int i = 0; i < 16; ++i) {
            float fz = __uint_as_float(fzr[i] << 16); fz = fminf(fmaxf(fz, -30.f), 30.f);
            const float em = __expf(-fz), sg = __builtin_amdgcn_rcpf(1.0f + em);
            run += __logf(lb + oml * sg); bb[i] = run; kk[i] = oml * em * sg;
            qq[i] = __uint_as_float(qr[i] << 16);
        }
        unsigned vraw[8];
#pragma unroll
        for (int i = 0; i < 8; ++i) vraw[i] = vr[2 * i] | (vr[2 * i + 1] << 16);
        { const int nitem = item + gstep;
          if (nitem < 2048) { const int c2 = nitem & 31, bh2 = nitem >> 5, hh2 = bh2 & 3, b2 = bh2 >> 2;
              const bf16_t* zq = p.za + ((size_t)b2 * 2048 + c2 * 64 + seg * 16) * ZW + hh2 * 128 + k;
#pragma unroll
              for (int i = 0; i < 16; ++i) { qr[i] = zq[(size_t)i * ZW]; fzr[i] = zq[(size_t)i * ZW + 512]; vr[i] = zq[(size_t)i * ZW + 1024]; } } }
        segsum[seg * 128 + k] = run;
        for (int i = tid; i < 64 * 72 / 2; i += 512) ((unsigned*)At)[i] = 0u;
        { const bf16_t* Sp = (const bf16_t*)p.L + (size_t)item * 16384;
#pragma unroll
          for (int i = 0; i < 4; ++i) { const int i8 = tid + 512 * i, v = i8 >> 4, k8 = (i8 & 15) * 8; *(u32x4*)(Sb + v * 136 + k8) = *(const u32x4*)(Sp + (size_t)i8 * 8); } }
        __syncthreads();
        float ss[4];
#pragma unroll
        for (int s = 0; s < 4; ++s) ss[s] = segsum[s * 128 + k];
        float off = 0.f;
#pragma unroll
        for (int s = 0; s < 4; ++s) if (s < seg) off += ss[s];
        const float eoff = __expf(off);
#pragma unroll
        for (int i = 0; i < 16; ++i) {
            const int t = seg * 16 + i;
            const float qi = qq[i] * __expf(bb[i]);
            Qi[t * 136 + k] = f2bf(qi);
            Qe[t * 136 + k] = f2bf(qi * eoff);
        }
        { const float ssg = seg == 0 ? ss[0] : seg == 1 ? ss[1] : seg == 2 ? ss[2] : ss[3];
          { const int base = 16 * (seg * (seg + 1) / 2);
#pragma unroll
            for (int j = 0; j < 16; ++j) Kh[(base + seg * 16 + j) * 136 + k] = f2bf(kk[j] * __expf(fminf(-bb[j], 80.f))); }
          if (seg < 3) {
#pragma unroll
              for (int j = 0; j < 16; ++j) kk[j] *= __expf(ssg - bb[j]);
              float racc = 0.f;
#pragma unroll
              for (int i = 1; i < 4; ++i) {
                  if (i > seg) {
                      const int base = 16 * (i * (i + 1) / 2);
                      const float fac = __expf(racc);
#pragma unroll
                      for (int j = 0; j < 16; ++j) Kh[(base + seg * 16 + j) * 136 + k] = f2bf(kk[j] * fac);
                      racc += ss[i];
                  }
              }
          } }
        *(u32x4*)(vT + k * 72 + seg * 16) = (u32x4){vraw[0], vraw[1], vraw[2], vraw[3]};
        *(u32x4*)(vT + k * 72 + seg * 16 + 8) = (u32x4){vraw[4], vraw[5], vraw[6], vraw[7]};
        __syncthreads();
        const int mt = wid >> 1, ntb = (wid & 1) * 4;
        u32x2 agr[4];
#pragma unroll
        for (int n = 0; n < 4; ++n) agr[n] = *(const u32x2*)(p.za + (rowc + 16 * mt + fr) * ZW + 1536 + hh * 128 + 16 * (ntb + n) + 4 * fq);
        for (int tl = wid; tl < 10; tl += 8) {
            const int i = tl < 1 ? 0 : (tl < 3 ? 1 : (tl < 6 ? 2 : 3)), j = tl - i * (i + 1) / 2, base = 16 * (i * (i + 1) / 2);
            f32x4 a4 = (f32x4){0.f, 0.f, 0.f, 0.f};
#pragma unroll
            for (int ks = 0; ks < 4; ++ks) {
                const bf16x8 a = *(const bf16x8*)(Qi + (16 * i + fr) * 136 + ks * 32 + fq * 8);
                const bf16x8 bq = *(const bf16x8*)(Kh + (base + 16 * j + fr) * 136 + ks * 32 + fq * 8);
                a4 = mfma16(a, bq, a4);
            }
#pragma unroll
            for (int jj = 0; jj < 4; ++jj) { const int tl_ = 4 * fq + jj; float v = a4[jj]; if (j == i && fr > tl_) v = 0.f;
                At[(16 * i + tl_) * 72 + 16 * j + fr] = f2bf(v); }
        }
        __syncthreads();
        f32x4 acc[4];
#pragma unroll
        for (int n = 0; n < 4; ++n) acc[n] = (f32x4){0.f, 0.f, 0.f, 0.f};
#pragma unroll
        for (int ks = 0; ks < 4; ++ks) {
            const bf16x8 qf = *(const bf16x8*)(Qe + (16 * mt + fr) * 136 + ks * 32 + fq * 8);
#pragma unroll
            for (int n = 0; n < 4; ++n) { const bf16x8 sf = *(const bf16x8*)(Sb + (16 * (ntb + n) + fr) * 136 + ks * 32 + fq * 8); acc[n] = mfma16(sf, qf, acc[n]); }
        }
#pragma unroll
        for (int ks = 0; ks < 2; ++ks) {
            const bf16x8 af = *(const bf16x8*)(At + (16 * mt + fr) * 72 + ks * 32 + fq * 8);
#pragma unroll
            for (int n = 0; n < 4; ++n) { const bf16x8 vf = *(const bf16x8*)(vT + (16 * (ntb + n) + fr) * 72 + ks * 32 + fq * 8); acc[n] = mfma16(vf, af, acc[n]); }
        }
        {
            float sq = 0.f;
#pragma unroll
            for (int n = 0; n < 4; ++n) sq += acc[n][0] * acc[n][0] + acc[n][1] * acc[n][1] + acc[n][2] * acc[n][2] + acc[n][3] * acc[n][3];
            sq += __shfl_xor(sq, 16); sq += __shfl_xor(sq, 32);
            if (fq == 0) ssq[(wid & 1) * 64 + 16 * mt + fr] = sq;
        }
        __syncthreads();
        {
            const int t = 16 * mt + fr;
            const float rs = rsqrtf((ssq[t] + ssq[64 + t]) * (1.0f / 128.0f) + 1e-6f);
            const size_t row = rowc + t;
#pragma unroll
            for (int n = 0; n < 4; ++n) {
                const u32x2 aw = agr[n];
                const float a0 = __uint_as_float(aw[0] << 16), a1 = __uint_as_float(aw[0] & 0xffff0000u), a2 = __uint_as_float(aw[1] << 16), a3 = __uint_as_float(aw[1] & 0xffff0000u);
                const f32x4 gq = ng4[n];
                u32x2 o; o[0] = pk2(acc[n][0] * rs * gq[0] * silu_f(a0), acc[n][1] * rs * gq[1] * silu_f(a1));
                o[1] = pk2(acc[n][2] * rs * gq[2] * silu_f(a2), acc[n][3] * rs * gq[3] * silu_f(a3));
                *(u32x2*)(p.h + row * 1024 + hh * 128 + 16 * (ntb + n) + 4 * fq) = o;
            }
        }
        __syncthreads();
    }
}

__device__ __forceinline__ void phase_attn(const Params& p, int e, unsigned char* smem) {
    const int tid = otid(), lane = tid & 63, wid = tid >> 6, fr = lane & 15, fq = lane >> 4;
    bf16_t* Ks = (bf16_t*)smem;
    bf16_t* VT = Ks + 256 * 72;
    bf16_t* Qs = VT + 64 * 264;
    bf16_t* P = Qs + 128 * 72;
    const int gstep = ogrid();
    u32x4 kv[4], vv[4], qv[2]; f32x4 krp[4], qrp[4];
    const int key = tid >> 1, dh = (tid & 1) * 32;
    const int qrow = tid >> 2, dq = (tid & 3) * 16;
    auto load_kv = [&](int item) {
        const int hk = item & 1, n = (item >> 1) & 15, b = item >> 5;
        const int row = b * 2048 + n * 128 - 128 + key;
        if ((n > 0) || (key >= 128)) {
            const bf16_t* kp = p.za + (size_t)row * ZW + 2560 + hk * 64 + dh;
#pragma unroll
            for (int i = 0; i < 4; ++i) { kv[i] = *(const u32x4*)(kp + 8 * i); vv[i] = *(const u32x4*)(kp + 128 + 8 * i); }
            if (dh == 0) {
#pragma unroll
                for (int i = 0; i < 4; ++i) krp[i] = *(const f32x4*)(p.rope + (size_t)row * 16 + 4 * i);
            }
        } else {
#pragma unroll
            for (int i = 0; i < 4; ++i) { kv[i] = (u32x4){0u, 0u, 0u, 0u}; vv[i] = (u32x4){0u, 0u, 0u, 0u}; krp[i] = (f32x4){1.f, 1.f, 1.f, 1.f}; }
        }
    };
    auto load_q = [&](int item, int g) {
        const int hk = item & 1, n = (item >> 1) & 15, b = item >> 5;
        const int row = b * 2048 + n * 128 + qrow;
        const bf16_t* qp = p.za + (size_t)row * ZW + 2048 + (hk * 4 + g) * 64 + dq;
        qv[0] = *(const u32x4*)qp; qv[1] = *(const u32x4*)(qp + 8);
        if (dq == 0) {
#pragma unroll
            for (int i = 0; i < 4; ++i) qrp[i] = *(const f32x4*)(p.rope + (size_t)row * 16 + 4 * i);
        }
    };
    if (obid() < 512) { load_kv(obid()); load_q(obid(), 0); }
    for (int item = obid(); item < 512; item += gstep) {
        const int hk = item & 1, n = (item >> 1) & 15, b = item >> 5;
        const int tok0 = b * 2048 + n * 128;
        {
            if (dh == 0) {
#pragma unroll
                for (int i = 0; i < 8; ++i) {
                    const unsigned w1 = kv[0][i >> 1], w2 = kv[1][i >> 1];
                    const float x1 = (i & 1) ? __uint_as_float(w1 & 0xffff0000u) : __uint_as_float(w1 << 16);
                    const float x2 = (i & 1) ? __uint_as_float(w2 & 0xffff0000u) : __uint_as_float(w2 << 16);
                    const float cs = krp[i >> 2][i & 3], sn = krp[2 + (i >> 2)][i & 3];
                    const unsigned r1 = f2bf(x1 * cs - x2 * sn), r2 = f2bf(x2 * cs + x1 * sn);
                    if (i & 1) { kv[0][i >> 1] = (kv[0][i >> 1] & 0xffffu) | (r1 << 16); kv[1][i >> 1] = (kv[1][i >> 1] & 0xffffu) | (r2 << 16); }
                    else { kv[0][i >> 1] = (kv[0][i >> 1] & 0xffff0000u) | r1; kv[1][i >> 1] = (kv[1][i >> 1] & 0xffff0000u) | r2; }
                }
            }
#pragma unroll
            for (int i = 0; i < 4; ++i) *(u32x4*)(Ks + key * 72 + dh + 8 * i) = kv[i];
#pragma unroll
            for (int i = 0; i < 4; ++i)
#pragma unroll
                for (int q = 0; q < 4; ++q) { const unsigned w = vv[i][q]; const int d = dh + 8 * i + 2 * q;
                    VT[d * 264 + key] = (bf16_t)(w & 0xffffu); VT[(d + 1) * 264 + key] = (bf16_t)(w >> 16); }
            if (item + gstep < 512) load_kv(item + gstep);
        }
        for (int g = 0; g < 4; ++g) {
            const int qh = hk * 4 + g;
            {
                float xf[16];
#pragma unroll
                for (int i = 0; i < 8; ++i) { xf[i] = ((i & 1) ? __uint_as_float(qv[0][i >> 1] & 0xffff0000u) : __uint_as_float(qv[0][i >> 1] << 16));
                    xf[8 + i] = ((i & 1) ? __uint_as_float(qv[1][i >> 1] & 0xffff0000u) : __uint_as_float(qv[1][i >> 1] << 16)); }
                if (dq == 0) {
#pragma unroll
                    for (int i = 0; i < 8; ++i) { const float cs = qrp[i >> 2][i & 3], sn = qrp[2 + (i >> 2)][i & 3], x1 = xf[i], x2 = xf[8 + i]; xf[i] = x1 * cs - x2 * sn; xf[8 + i] = x2 * cs + x1 * sn; }
                }
                u32x4 o0, o1;
#pragma unroll
                for (int i = 0; i < 4; ++i) { o0[i] = pk2(xf[2 * i] * 0.125f, xf[2 * i + 1] * 0.125f); o1[i] = pk2(xf[8 + 2 * i] * 0.125f, xf[8 + 2 * i + 1] * 0.125f); }
                *(u32x4*)(Qs + qrow * 72 + dq) = o0; *(u32x4*)(Qs + qrow * 72 + dq + 8) = o1;
                if (g < 3) load_q(item, g + 1); else if (item + gstep < 512) load_q(item + gstep, 0);
            }
            __syncthreads();
            const int nt0 = 2 * (wid >> 1);
            f32x4 sacc[10];
#pragma unroll
            for (int i = 0; i < 10; ++i) sacc[i] = (f32x4){0.f, 0.f, 0.f, 0.f};
#pragma unroll
            for (int ks = 0; ks < 2; ++ks) {
                const bf16x8 qf = *(const bf16x8*)(Qs + (16 * wid + fr) * 72 + ks * 32 + fq * 8);
#pragma unroll
                for (int i = 0; i < 10; ++i) { const bf16x8 kf = *(const bf16x8*)(Ks + (16 * (nt0 + i) + fr) * 72 + ks * 32 + fq * 8); sacc[i] = mfma16(kf, qf, sacc[i]); }
            }
            {
                const float sink = p.sinks[e * 8 + qh];
                const int ql = 16 * wid + fr;
                float mx = -1e30f;
#pragma unroll
                for (int i = 0; i < 10; ++i)
#pragma unroll
                    for (int j = 0; j < 4; ++j) { const int key = 16 * (nt0 + i) + 4 * fq + j, rel = 128 + ql - key;
                        const bool ok = (rel >= 0) && (rel < 128) && ((n > 0) || (key >= 128));
                        const float sv = ok ? sacc[i][j] : -1e30f; sacc[i][j] = sv; mx = fmaxf(mx, sv); }
                mx = fmaxf(mx, __shfl_xor(mx, 16)); mx = fmaxf(mx, __shfl_xor(mx, 32));
                mx = fmaxf(mx, sink);
                float sum = 0.f;
#pragma unroll
                for (int i = 0; i < 10; ++i)
#pragma unroll
                    for (int j = 0; j < 4; ++j) { const float pv = (sacc[i][j] > -1e29f) ? __expf(sacc[i][j] - mx) : 0.f; sacc[i][j] = pv; sum += pv; }
                sum += __shfl_xor(sum, 16); sum += __shfl_xor(sum, 32);
                const float inv = 1.0f / (sum + __expf(sink - mx));
#pragma unroll
                for (int i = 0; i < 10; ++i) { u32x2 o; o[0] = pk2(sacc[i][0] * inv, sacc[i][1] * inv); o[1] = pk2(sacc[i][2] * inv, sacc[i][3] * inv);
                    *(u32x2*)(P + ql * 264 + 16 * (nt0 + i) + 4 * fq) = o; }
            }
            __syncthreads();
            f32x4 oacc[4];
#pragma unroll
            for (int mt2 = 0; mt2 < 4; ++mt2) oacc[mt2] = (f32x4){0.f, 0.f, 0.f, 0.f};
#pragma unroll
            for (int s5 = 0; s5 < 5; ++s5) {
                const int ks = (wid >> 1) + s5;
                const bf16x8 pf = *(const bf16x8*)(P + (16 * wid + fr) * 264 + ks * 32 + fq * 8);
#pragma unroll
                for (int mt2 = 0; mt2 < 4; ++mt2) { const bf16x8 vf = *(const bf16x8*)(VT + (16 * mt2 + fr) * 264 + ks * 32 + fq * 8); oacc[mt2] = mfma16(vf, pf, oacc[mt2]); }
            }
#pragma unroll
            for (int mt2 = 0; mt2 < 4; ++mt2) { u32x2 o; o[0] = pk2(oacc[mt2][0], oacc[mt2][1]); o[1] = pk2(oacc[mt2][2], oacc[mt2][3]);
                *(u32x2*)(p.h + (size_t)(tok0 + 16 * wid + fr) * 1024 + 512 + qh * 64 + 16 * mt2 + 4 * fq) = o; }
            __syncthreads();
        }
    }
}

template <int W> __device__ __forceinline__ void pool_task(const Params& p, int g, int row, int c8) {
    const int t = row & 2047, col = g * 256 + c8;
    u32x4 v[W];
#pragma unroll
    for (int j = 0; j < W; ++j) { const int rj = (j <= t) ? row - j : row; v[j] = *(const u32x4*)(p.h + (size_t)rj * 1024 + col); }
    float s[8];
#pragma unroll
    for (int e = 0; e < 8; ++e) s[e] = 0.f;
#pragma unroll
    for (int j = 0; j < W; ++j) {
        const float wgt = (j <= t) ? 1.0f : 0.0f;
#pragma unroll
        for (int q = 0; q < 4; ++q) { s[2 * q] += wgt * __uint_as_float(v[j][q] << 16); s[2 * q + 1] += wgt * __uint_as_float(v[j][q] & 0xffff0000u); }
    }
    const int cnt = (t + 1 < W) ? (t + 1) : W;
    const float ic = 1.0f / (float)cnt;
    u32x4 o;
#pragma unroll
    for (int q = 0; q < 4; ++q) o[q] = pk2(s[2 * q] * ic - __uint_as_float(v[0][q] << 16), s[2 * q + 1] * ic - __uint_as_float(v[0][q] & 0xffff0000u));
    *(u32x4*)(p.za + ((size_t)g * MTOK + row) * 256 + c8) = o;
}
__device__ __forceinline__ void phase_pool(const Params& p) {
    for (int T = obid() * 512 + otid(); T < 4 * MTOK * 32; T += ogrid() * 512) {
        const int g = T >> 20, row = (T >> 5) & (MTOK - 1), c8 = (T & 31) * 8;
        if (g == 0) pool_task<2>(p, g, row, c8);
        else if (g == 1) pool_task<4>(p, g, row, c8);
        else if (g == 2) pool_task<8>(p, g, row, c8);
        else pool_task<16>(p, g, row, c8);
    }
}


template <int W> __device__ __forceinline__ void poolmix_quad(const Params& p, bf16_t* PT, int g, int r0, int R0, int c8) {
    const int col = g * 256 + c8, t0 = (R0 & 2047) + r0 - (W - 1);
    const bf16_t* base = p.h + (size_t)(R0 + r0 - (W - 1)) * 1024 + col;
    u32x4 v[W + 3];
#pragma unroll
    for (int i = 0; i < W + 3; ++i) { const int ii = (t0 + i >= 0) ? i : (W - 1); v[i] = *(const u32x4*)(base + (ptrdiff_t)ii * 1024); }
    float s[8];
#pragma unroll
    for (int e = 0; e < 8; ++e) s[e] = 0.f;
#pragma unroll
    for (int i = 0; i < W; ++i) {
        const float wgt = (t0 + i >= 0) ? 1.0f : 0.0f;
#pragma unroll
        for (int q = 0; q < 4; ++q) { s[2 * q] += wgt * __uint_as_float(v[i][q] << 16); s[2 * q + 1] += wgt * __uint_as_float(v[i][q] & 0xffff0000u); }
    }
#pragma unroll
    for (int qr = 0; qr < 4; ++qr) {
        if (qr > 0) {
            const float wo = (t0 + qr - 1 >= 0) ? 1.0f : 0.0f;
#pragma unroll
            for (int q = 0; q < 4; ++q) {
                s[2 * q] += __uint_as_float(v[qr + W - 1][q] << 16) - wo * __uint_as_float(v[qr - 1][q] << 16);
                s[2 * q + 1] += __uint_as_float(v[qr + W - 1][q] & 0xffff0000u) - wo * __uint_as_float(v[qr - 1][q] & 0xffff0000u);
            }
        }
        const int t = t0 + W - 1 + qr, cnt = (t + 1 < W) ? (t + 1) : W;
        const float ic = 1.0f / (float)cnt;
        u32x4 o;
#pragma unroll
        for (int q = 0; q < 4; ++q) o[q] = pk2(s[2 * q] * ic - __uint_as_float(v[qr + W - 1][q] << 16), s[2 * q + 1] * ic - __uint_as_float(v[qr + W - 1][q] & 0xffff0000u));
        *(u32x4*)(PT + (r0 + qr) * 1032 + col) = o;
    }
}
template <int W> __device__ __forceinline__ void poolmix_task(const Params& p, bf16_t* PT, int g, int r, int row, int c8) {
    const int t = row & 2047, col = g * 256 + c8;
    u32x4 v[W];
#pragma unroll
    for (int j = 0; j < W; ++j) { const int rj = (j <= t) ? row - j : row; v[j] = *(const u32x4*)(p.h + (size_t)rj * 1024 + col); }
    float s[8];
#pragma unroll
    for (int e = 0; e < 8; ++e) s[e] = 0.f;
#pragma unroll
    for (int j = 0; j < W; ++j) {
        const float wgt = (j <= t) ? 1.0f : 0.0f;
#pragma unroll
        for (int q = 0; q < 4; ++q) { s[2 * q] += wgt * __uint_as_float(v[j][q] << 16); s[2 * q + 1] += wgt * __uint_as_float(v[j][q] & 0xffff0000u); }
    }
    const int cnt = (t + 1 < W) ? (t + 1) : W;
    const float ic = 1.0f / (float)cnt;
    u32x4 o;
#pragma unroll
    for (int q = 0; q < 4; ++q) o[q] = pk2(s[2 * q] * ic - __uint_as_float(v[0][q] << 16), s[2 * q + 1] * ic - __uint_as_float(v[0][q] & 0xffff0000u));
    *(u32x4*)(PT + r * 1032 + col) = o;
}
__device__ __forceinline__ void phase_poolmix(const Params& p, int l, unsigned char* smem) {
    typedef float f32x2v __attribute__((ext_vector_type(2)));
    const int tid = otid(), lane = tid & 63, wid = __builtin_amdgcn_readfirstlane(tid >> 6);
    bf16_t* PT = (bf16_t*)smem;
    f32x2v* Pst = (f32x2v*)(smem + 132096);
    f32x2v* Sst = (f32x2v*)(smem + 132096 + 4096);
    const int g = wid >> 1, cbase = g * 256 + (wid & 1) * 128;
    const bf16_t* Wt = p.wt_pool + (size_t)(l >> 1) * 4 * 65536 + (size_t)g * 65536 + (size_t)(wid & 1) * 8 * 4096;
    bf16_t* hdst = (bf16_t*)p.L;
    const float* lng = p.ln_g + (l * 2) * 1024; const float* lnb = p.ln_b + (l * 2) * 1024;
    for (int item = obid(); item < 512; item += ogrid()) {
        const int R0 = item * 64, b = R0 >> 11;
        int lane_o = lane; asm volatile("" : "+v"(lane_o));
        const int fr = lane_o & 15, fq = lane_o >> 4;
        {
            const int r0 = (tid >> 5) * 4, c8 = (tid & 31) * 8;
            poolmix_quad<2>(p, PT, 0, r0, R0, c8);
            poolmix_quad<4>(p, PT, 1, r0, R0, c8);
            poolmix_quad<8>(p, PT, 2, r0, R0, c8);
            poolmix_quad<16>(p, PT, 3, r0, R0, c8);
        }
        __syncthreads();
#pragma clang loop unroll(disable)
        for (int rh = 0; rh < 2; ++rh) {
            f32x4 acc[2][8];
#pragma unroll
            for (int mt = 0; mt < 2; ++mt)
#pragma unroll
                for (int nt = 0; nt < 8; ++nt) acc[mt][nt] = (f32x4){0.f, 0.f, 0.f, 0.f};
            const bf16_t* wb0 = Wt + (size_t)(fq * 16 + fr) * 8;
            asm volatile("" : "+v"(wb0));
            const __attribute__((address_space(1))) bf16_t* wb = (const __attribute__((address_space(1))) bf16_t*)wb0;
            const bf16_t* pb = PT + (32 * rh + fr) * 1032 + g * 256 + fq * 8;
            bf16x8 wf[8];
#pragma unroll
            for (int nt = 0; nt < 8; ++nt) wf[nt] = *(const __attribute__((address_space(1))) bf16x8*)(wb + nt * 4096);
#pragma unroll
            for (int ks = 0; ks < 8; ++ks) {
                bf16x8 wn[8];
                if (ks < 7) {
#pragma unroll
                    for (int nt = 0; nt < 8; ++nt) wn[nt] = *(const __attribute__((address_space(1))) bf16x8*)(wb + nt * 4096 + (ks + 1) * 512);
                }
                bf16x8 pf[2];
#pragma unroll
                for (int mt = 0; mt < 2; ++mt) pf[mt] = *(const bf16x8*)(pb + mt * 16 * 1032 + ks * 32);
#pragma unroll
                for (int nt = 0; nt < 8; ++nt)
#pragma unroll
                    for (int mt = 0; mt < 2; ++mt) acc[mt][nt] = mfma16(wf[nt], pf[mt], acc[mt][nt]);
                if (ks < 7) {
#pragma unroll
                    for (int nt = 0; nt < 8; ++nt) wf[nt] = wn[nt];
                }
            }
            {
                const float* gp = p.mod + ((size_t)l * 16 + b) * 6144 + 2048 + cbase + 4 * fq;
                f32x4 gv[8];
#pragma unroll
                for (int nt = 0; nt < 8; ++nt) gv[nt] = *(const f32x4*)(gp + 16 * nt);
                f32x4 xi[2][8];
#pragma unroll
                for (int mt = 0; mt < 2; ++mt) {
                    const float* xr = p.out + (size_t)(R0 + 32 * rh + 16 * mt + fr) * 1024 + cbase + 4 * fq;
#pragma unroll
                    for (int nt = 0; nt < 8; ++nt) xi[mt][nt] = *(const f32x4*)(xr + 16 * nt);
                }
#pragma unroll
                for (int mt = 0; mt < 2; ++mt) {
                    float sm = 0.f;
#pragma unroll
                    for (int nt = 0; nt < 8; ++nt) { const f32x4 v = xi[mt][nt] * ALPHA_C + gv[nt] * acc[mt][nt]; acc[mt][nt] = v; sm += (v[0] + v[1]) + (v[2] + v[3]); }
                    sm += __shfl_xor(sm, 16); sm += __shfl_xor(sm, 32);
                    const float mw = sm * (1.0f / 128.0f); float q = 0.f;
#pragma unroll
                    for (int nt = 0; nt < 8; ++nt) { const f32x4 d = acc[mt][nt] - mw; q += (d[0] * d[0] + d[1] * d[1]) + (d[2] * d[2] + d[3] * d[3]); }
                    q += __shfl_xor(q, 16); q += __shfl_xor(q, 32);
                    if (fq == 0) Pst[(16 * mt + fr) * 8 + wid] = (f32x2v){mw, q};
                }
            }
            __syncthreads();
            if (tid < 32) {
                float mt8[8], m28[8]; float ms = 0.f;
#pragma unroll
                for (int w = 0; w < 8; ++w) { const f32x2v a = Pst[tid * 8 + w]; mt8[w] = a.x; m28[w] = a.y; ms += a.x; }
                const float mean = ms * 0.125f; float q = 0.f;
#pragma unroll
                for (int w = 0; w < 8; ++w) { const float dm = mt8[w] - mean; q += m28[w] + 128.0f * dm * dm; }
                Sst[tid] = (f32x2v){mean, 1.0f / sqrtf(q * (1.0f / 1024.0f) + 1e-5f)};
            }
            __syncthreads();
            {
                const float* mp = p.mod + ((size_t)l * 16 + b) * 6144 + cbase + 4 * fq;
#pragma unroll
                for (int nt = 0; nt < 8; ++nt) {
                    const int co = cbase + 16 * nt + 4 * fq;
                    const f32x4 gg = *(const f32x4*)(lng + co), bb = *(const f32x4*)(lnb + co);
                    const f32x4 sc = *(const f32x4*)(mp + 4096 + 16 * nt), sh = *(const f32x4*)(mp + 3072 + 16 * nt);
#pragma unroll
                    for (int mt = 0; mt < 2; ++mt) {
                        const int r = 16 * mt + fr; const f32x2v sr = Sst[r];
                        const size_t off = (size_t)(R0 + 32 * rh + r) * 1024 + co;
                        const f32x4 y = (acc[mt][nt] - sr.x) * sr.y * gg + bb;
                        *(f32x4*)(p.out + off) = y;
                        const f32x4 hh = y * (sc + 1.0f) + sh;
                        u32x2 o; o[0] = pk2(hh[0], hh[1]); o[1] = pk2(hh[2], hh[3]);
                        *(u32x2*)(hdst + off) = o;
                    }
                }
            }
        }
        __syncthreads();
    }
}

__device__ __forceinline__ void phase_fixup(const Params& p, int l) {
    const float* cw = p.conv_w + (size_t)l * 3 * FF; const float* cb = p.conv_b + (size_t)l * FF;
    for (int task = obid() * 512 + otid(); task < 512 * 704; task += ogrid() * 512) {
        const int s = task / 704, f = (task % 704) * 4;
        const float* sd = p.side + (size_t)s * (6 * FF) + f;
        const f32x4 u0 = *(const f32x4*)(sd), u1 = *(const f32x4*)(sd + FF), v0 = *(const f32x4*)(sd + 2 * FF), v1 = *(const f32x4*)(sd + 3 * FF);
        f32x4 um2 = (f32x4){0.f, 0.f, 0.f, 0.f}, um1 = um2;
        if ((s & 31) != 0) { const float* sp = sd - 6 * FF; um2 = *(const f32x4*)(sp + 4 * FF); um1 = *(const f32x4*)(sp + 5 * FF); }
        const f32x4 w0 = *(const f32x4*)(cw + f), w1 = *(const f32x4*)(cw + FF + f), w2 = *(const f32x4*)(cw + 2 * FF + f), bb = *(const f32x4*)(cb + f);
        const f32x4 c0 = bb + w0 * um2 + w1 * um1 + w2 * u0, c1 = bb + w0 * um1 + w1 * u0 + w2 * u1;
        f32x4 r0, r1;
#pragma unroll
        for (int e = 0; e < 4; ++e) { r0[e] = silu_f(c0[e]) * v0[e]; r1[e] = silu_f(c1[e]) * v1[e]; }
        u32x2 o0, o1; o0[0] = pk2(r0[0], r0[1]); o0[1] = pk2(r0[2], r0[3]); o1[0] = pk2(r1[0], r1[1]); o1[1] = pk2(r1[2], r1[3]);
        *(u32x2*)(p.za + (size_t)(64 * s) * FF + f) = o0;
        *(u32x2*)(p.za + (size_t)(64 * s + 1) * FF + f) = o1;
    }
}

__device__ __forceinline__ void gemm_in(const Params& p, int e, LAS unsigned char* lds) {
    pg8::StaticOrder S; S.init(MTOK, ZW, ogrid(), obid());
    pg8::Gemm g{p.h, p.wt_in + (size_t)e * ZW * 1024, MTOK, ZW, 1024};
    EpiStoreBf16 E{p.za, ZW};
    pg8::gemm_phase(lds, g, S, E);
}
__device__ __forceinline__ LnFuse make_lnfuse(const Params& p, int l, int sub) {
    LnFuse f;
    f.xin = (l == 0 && sub == 0) ? p.x_in : p.out; f.xout = p.out;
    f.gate = p.mod + (size_t)l * 16 * 6144 + (sub == 0 ? 2048 : 5120);
    f.lng = p.ln_g + (l * 2 + sub) * 1024; f.lnb = p.ln_b + (l * 2 + sub) * 1024;
    const bool last = (l == 3 && sub == 1);
    const int nl = sub == 0 ? l : l + 1;
    f.msc = last ? nullptr : p.mod + (size_t)nl * 16 * 6144 + (sub == 0 ? 4096 : 1024);
    f.msh = last ? nullptr : p.mod + (size_t)nl * 16 * 6144 + (sub == 0 ? 3072 : 0);
    f.hout = p.h;
    f.xbuf = (unsigned long long*)p.xbuf; f.cnt = p.bar + XCD_BAR_WORDS; f.tmo = p.bar + XB_TMO; f.want = 32u * (unsigned)((l >> 1) * 3 + ((l & 1) ? 3 : (sub + 1)));
    return f;
}
__device__ __forceinline__ void gemm_out(const Params& p, int l, LAS unsigned char* lds) {
    pg8::Gemm g{p.h, p.wt_out + (size_t)(l >> 1) * 1024 * 1024, MTOK, 1024, 1024};
    EpiResidLn<false> E{make_lnfuse(p, l, 0)};
#pragma clang loop unroll(disable)
    for (int pass = 0; pass < 2; ++pass) {
        pg8::PassOrder S; S.S.init(MTOK, 1024, ogrid(), obid()); S.pass = pass;
        pg8::gemm_phase(lds, g, S, E);
    }
}
__device__ __forceinline__ void gemm_pool(const Params& p, int l, LAS unsigned char* lds) {
    int kdim = 256; asm volatile("" : "+s"(kdim));
    pg8::Gemm g{p.za, p.wt_pool + (size_t)(l >> 1) * 4 * 65536, 4 * MTOK, 256, kdim};
    EpiResidLn<true> E{make_lnfuse(p, l, 0)};
#pragma clang loop unroll(disable)
    for (int pass = 0; pass < 2; ++pass) {
        pg8::PoolPassOrder S{ogrid(), obid(), pass};
        pg8::gemm_phase(lds, g, S, E);
    }
}
__device__ __forceinline__ void gemm_up(const Params& p, int l, LAS unsigned char* lds) {
    pg8::StaticOrder S; S.init(MTOK, 2 * FF, ogrid(), obid());
    pg8::Gemm g{(l & 1) ? (const bf16_t*)p.L : (const bf16_t*)p.h, p.wt_up + (size_t)l * 2 * FF * 1024, MTOK, 2 * FF, 1024};
    EpiConvGate E{p.za, p.side, p.conv_w + (size_t)l * 3 * FF, p.conv_b + (size_t)l * FF};
    pg8::gemm_phase(lds, g, S, E);
}
__device__ __forceinline__ void gemm_down(const Params& p, int l, LAS unsigned char* lds) {
    pg8::Gemm g{p.za, p.wt_down + (size_t)l * 1024 * FF, MTOK, 1024, FF};
    EpiResidLn<false> E{make_lnfuse(p, l, 1)};
#pragma clang loop unroll(disable)
    for (int pass = 0; pass < 2; ++pass) {
        pg8::PassOrder S; S.S.init(MTOK, 1024, ogrid(), obid()); S.pass = pass;
        pg8::gemm_phase(lds, g, S, E);
    }
}

enum { PH_PREP = 0, PH_H0, PH_GEMM_IN, PH_MIX1, PH_HGRNB, PH_HGRNC, PH_GEMM_OUT, PH_POOL, PH_GEMM_POOL, PH_LN0, PH_GEMM_UP, PH_FIXUP, PH_GEMM_DOWN, PH_LN1 };

__device__ __forceinline__ void run_phase(const Params& p, int ph, int l, unsigned char* smem) {
    LAS unsigned char* lds = (LAS unsigned char*)smem;
    switch (ph) {
        case PH_PREP: phase_prep(p, smem); break;
        case PH_H0: phase_h0(p); break;
        case PH_GEMM_IN: gemm_in(p, l >> 1, lds); break;
        case PH_MIX1: phase_attn(p, l >> 1, smem); phase_hgrnA(p, l >> 1, smem); break;
        case PH_HGRNB: phase_hgrnB(p); break;
        case PH_HGRNC: phase_hgrnC(p, l >> 1, smem); break;
        case PH_GEMM_OUT: gemm_out(p, l, lds); break;
        case PH_POOL: phase_poolmix(p, l, smem); break;
        case PH_GEMM_UP: gemm_up(p, l, lds); break;
        case PH_FIXUP: phase_fixup(p, l); break;
        case PH_GEMM_DOWN: gemm_down(p, l, lds); break;
    }
}


#define XB_XCNT(j)  (256  + 64 * (j))
#define XB_XSUB(j)  (1280 + 64 * (j))
#define XB_XGEN(j)  (2304 + 64 * (j))
#define XB_TOP      3328
#define XB_TOPGEN   3392
#define XB_SPIN_CAP (1u << 18)
__device__ __forceinline__ unsigned xb_ld(unsigned* p)              { return __hip_atomic_load(p, __ATOMIC_RELAXED, __HIP_MEMORY_SCOPE_AGENT); }
__device__ __forceinline__ unsigned xb_add(unsigned* p, unsigned v) { return __hip_atomic_fetch_add(p, v, __ATOMIC_RELAXED, __HIP_MEMORY_SCOPE_AGENT); }
__device__ __forceinline__ unsigned xb_xcc_id() { return (unsigned)__builtin_amdgcn_s_getreg((3 << 11) | 20) & 0xFu; }
#define XB_SPIN(cond, bar) do { unsigned _sp = 0; while (cond) { __builtin_amdgcn_s_sleep(1); \
    if ((++_sp & 255u) == 0u) { if (xb_ld(&(bar)[XB_TMO])) break; if (_sp > XB_SPIN_CAP) { atomicAdd(&(bar)[XB_TMO], 1u); break; } } } } while (0)
struct XcdBarrier { unsigned* bar; unsigned x; volatile LAS unsigned* st; };
__device__ __forceinline__ XcdBarrier xcd_barrier_post(unsigned* bar, volatile LAS unsigned* st) {
    XcdBarrier b; b.bar = bar; b.x = xb_xcc_id(); b.st = st;
    if (threadIdx.x == 0) (void)xb_add(&bar[XB_XCNT(b.x)], 1u);
    return b;
}
__device__ __forceinline__ void xcd_barrier_complete(unsigned* bar, unsigned x, unsigned& nloc, unsigned& nx) {
    const unsigned G = gridDim.x * gridDim.y * gridDim.z;
    unsigned sum, cnt, mine, sp = 0u;
    for (;;) {
        sum = 0u; cnt = 0u; mine = 0u;
#pragma unroll
        for (unsigned j = 0; j < 16; ++j) { const unsigned c = xb_ld(&bar[XB_XCNT(j)]); sum += c; cnt += (c > 0u) ? 1u : 0u; mine = (j == x) ? c : mine; }
        if (sum == G) break;
        __builtin_amdgcn_s_sleep(1);
        if ((++sp & 255u) == 0u) { if (xb_ld(&bar[XB_TMO])) break; if (sp > XB_SPIN_CAP) { atomicAdd(&bar[XB_TMO], 1u); break; } }
    }
    nloc = mine > 0u ? mine : 1u; nx = cnt > 0u ? cnt : 1u;
}
__device__ __forceinline__ void xcd_barrier(const XcdBarrier& b) {
    asm volatile("s_waitcnt vmcnt(0)" ::: "memory");
    __syncthreads();
    if (threadIdx.x == 0) {
        unsigned* bar = b.bar;
        __builtin_amdgcn_s_waitcnt(0);
        unsigned nloc = b.st[0], nx = b.st[1];
        if (nloc == 0u) { xcd_barrier_complete(bar, b.x, nloc, nx); b.st[0] = nloc; b.st[1] = nx; }
        const unsigned old = xb_add(&bar[XB_XSUB(b.x)], 1u);
        const unsigned gen = old / nloc;
        if (old + 1u == (gen + 1u) * nloc) {
            __builtin_amdgcn_fence(__ATOMIC_RELEASE, "agent");
            asm volatile("s_waitcnt vmcnt(0)" ::: "memory");
            const unsigned og = xb_add(&bar[XB_TOP], 1u);
            const unsigned tg = og / nx;
            if (og + 1u == (tg + 1u) * nx) xb_add(&bar[XB_TOPGEN], 1u);
            else XB_SPIN(xb_ld(&bar[XB_TOPGEN]) == tg, bar);
            __builtin_amdgcn_fence(__ATOMIC_ACQUIRE, "agent");
            xb_add(&bar[XB_XGEN(b.x)], 1u);
            asm volatile("s_waitcnt vmcnt(0)" ::: "memory");
        } else {
            XB_SPIN(xb_ld(&bar[XB_XGEN(b.x)]) == gen, bar);
            __builtin_amdgcn_fence(__ATOMIC_ACQUIRE, "agent");
            asm volatile("s_waitcnt vmcnt(0)" ::: "memory");
        }
    }
    __syncthreads();
}

__device__ __forceinline__ void decode_step(int step, int& ph, int& l) {
    if (step < 2) { ph = step; l = 0; return; }
    const int s2 = step - 2, pair = s2 / 12, r = s2 % 12;
    const unsigned long long tbl = 0x2ull | (0x3ull << 4) | (0x4ull << 8) | (0x5ull << 12) | (0x6ull << 16) | (0xAull << 20) | (0xBull << 24) | (0xCull << 28)
                                 | (0x7ull << 32) | (0xAull << 36) | (0xBull << 40) | (0xCull << 44);
    ph = (int)((tbl >> (4 * r)) & 15ull);
    l = 2 * pair + (r >= 8 ? 1 : 0);
}
constexpr int NSTEPS = 26;
#if MEGA
__global__ void __launch_bounds__(512, 2) fwd_mega(Params p) {
    extern __shared__ __attribute__((aligned(16))) unsigned char smem[];
    cg::grid_group grid = cg::this_grid();
    volatile LAS unsigned* st = (volatile LAS unsigned*)((LAS unsigned char*)smem + (LDS_BYTES - 16));
    if (threadIdx.x == 0) { st[0] = 0u; st[1] = 0u; }
    __syncthreads();
    const XcdBarrier xb = xcd_barrier_post(p.bar, st);
#pragma clang loop unroll(disable)
    for (int step = 0; step < NSTEPS; ++step) {
        int ph, l; decode_step(step, ph, l);
        run_phase(p, ph, l, smem);
#ifdef PROBE_MASK
        if ((PROBE_MASK >> ph) & 1) { xcd_barrier(xb); run_phase(p, ph, l, smem); }
#endif
        if (p.bar == nullptr) grid.sync();
        if (step + 1 < NSTEPS) xcd_barrier(xb);
    }
}
#else
__global__ void __launch_bounds__(512, 2) fwd_phase(Params p, int step) {
    extern __shared__ __attribute__((aligned(16))) unsigned char smem[];
    int ph, l; decode_step(step, ph, l);
    run_phase(p, ph, l, smem);
}
#endif

extern "C" void kernel_launch(void* const* d_in, const int* in_sizes, int n_in, void* d_out, int out_size, void* d_ws, size_t ws_size, hipStream_t stream) {
    (void)in_sizes; (void)n_in; (void)out_size; (void)ws_size;
    Params p{};
    p.x_in = (const float*)d_in[0]; p.c = (const float*)d_in[1]; p.pos = (const int*)d_in[2]; p.ada_w = (const float*)d_in[3]; p.ada_b = (const float*)d_in[4];
    p.ln_g = (const float*)d_in[5]; p.ln_b = (const float*)d_in[6]; p.w_in = (const float*)d_in[7]; p.w_out = (const float*)d_in[8]; p.lb_raw = (const float*)d_in[9];
    p.norm_g = (const float*)d_in[10]; p.sinks = (const float*)d_in[11]; p.pool_w = (const float*)d_in[12]; p.pool_scale = (const float*)d_in[13];
    p.w_up = (const float*)d_in[14]; p.conv_w = (const float*)d_in[15]; p.conv_b = (const float*)d_in[16]; p.w_down = (const float*)d_in[17];
    p.out = (float*)d_out;
    char* w = (char*)d_ws; size_t off = 0;
    auto take = [&](size_t bytes) { char* r = w + off; off += (bytes + 255) & ~(size_t)255; return r; };
    p.wt_in = (bf16_t*)take((size_t)2 * ZW * 1024 * 2);
    p.wt_out = (bf16_t*)take((size_t)2 * 1024 * 1024 * 2);
    p.wt_up = (bf16_t*)take((size_t)4 * 2 * FF * 1024 * 2);
    p.wt_down = (bf16_t*)take((size_t)4 * 1024 * FF * 2);
    p.wt_pool = (bf16_t*)take((size_t)2 * 4 * 65536 * 2);
    p.mod = (float*)take((size_t)4 * 16 * 6144 * 4);
    p.rope = (float*)take((size_t)MTOK * 16 * 4);
    p.h = (bf16_t*)take((size_t)MTOK * 1024 * 2);
    p.za = (bf16_t*)take((size_t)MTOK * ZW * 2);
    p.L = (float*)take((size_t)2048 * 16384 * 4);
    p.dec = (float*)take((size_t)2048 * 128 * 4);
    p.side = (float*)take((size_t)512 * 6 * FF * 4);
    p.bar = (unsigned*)take((size_t)BAR_TOTAL_WORDS * 4);
    p.xbuf = (unsigned*)take((size_t)MTOK * 4 * 8);
#if MEGA
    static bool attr_set = false;
    if (!attr_set) { (void)hipFuncSetAttribute((const void*)fwd_mega, hipFuncAttributeMaxDynamicSharedMemorySize, LDS_BYTES); attr_set = true; }
    int dev = 0, cus = 0, per_cu = 0;
    (void)hipGetDevice(&dev);
    (void)hipDeviceGetAttribute(&cus, hipDeviceAttributeMultiprocessorCount, dev);
    (void)hipOccupancyMaxActiveBlocksPerMultiprocessor(&per_cu, fwd_mega, 512, LDS_BYTES);
    if (per_cu < 1) per_cu = 1;
    int grid = 256;
    (void)cus;
    (void)hipMemsetAsync(p.bar, 0, (size_t)BAR_TOTAL_WORDS * 4, stream);
    void* args[] = {&p};
    hipError_t err = hipLaunchCooperativeKernel((const void*)fwd_mega, dim3(grid), dim3(512), args, LDS_BYTES, stream);
    if (err != hipSuccess) fprintf(stderr, "cooperative launch failed: %s (grid %d)\n", hipGetErrorString(err), grid);
#else
    static bool attr_set = false;
    if (!attr_set) { (void)hipFuncSetAttribute((const void*)fwd_phase, hipFuncAttributeMaxDynamicSharedMemorySize, LDS_BYTES); attr_set = true; }
    for (int step = 0; step < NSTEPS; ++step) fwd_phase<<<256, 512, LDS_BYTES, stream>>>(p, step);
#endif
}
```

```cpp
#include <hip/hip_runtime.h>
#include <hip/hip_cooperative_groups.h>
#include <cstdio>
namespace cg = cooperative_groups;

#ifndef MEGA
#define MEGA 1
#endif

#define LAS __attribute__((address_space(3)))
typedef unsigned short bf16_t;
typedef short bf16x8 __attribute__((ext_vector_type(8)));
typedef float f32x4 __attribute__((ext_vector_type(4)));
typedef unsigned u32x4 __attribute__((ext_vector_type(4)));
typedef unsigned u32x2 __attribute__((ext_vector_type(2)));

constexpr int MTOK = 32768, DM = 1024, SEQ_T = 2048, NB = 16;
constexpr int ZW = 2816, FF = 2816;
constexpr float ALPHA_C = 1.681792830507429f;
constexpr int LDS_BYTES = 163840;
#define XB_TMO      128
#define XCD_BAR_WORDS 3456
constexpr int BAR_TOTAL_WORDS = XCD_BAR_WORDS + 128 * 64;

struct Params {
    const float* x_in; const float* c; const int* pos; const float* ada_w; const float* ada_b;
    const float* ln_g; const float* ln_b; const float* w_in; const float* w_out; const float* lb_raw;
    const float* norm_g; const float* sinks; const float* pool_w; const float* pool_scale;
    const float* w_up; const float* conv_w; const float* conv_b; const float* w_down;
    float* out;
    bf16_t* wt_in; bf16_t* wt_out; bf16_t* wt_up; bf16_t* wt_down; bf16_t* wt_pool;
    float* mod; float* rope; bf16_t* h; bf16_t* za; float* L; float* dec; float* side; unsigned* bar; unsigned* xbuf;
};


constexpr int PARAM_OFF = LDS_BYTES - 512;
__device__ __forceinline__ unsigned long long ldq(const unsigned* lp, int idx) {
    const unsigned lo = __builtin_amdgcn_readfirstlane(lp[2 * idx]), hi = __builtin_amdgcn_readfirstlane(lp[2 * idx + 1]);
    return ((unsigned long long)hi << 32) | lo;
}
__device__ __forceinline__ Params load_params(const unsigned char* smem) {
    const unsigned* lp = (const unsigned*)(smem + PARAM_OFF);
    Params p;
    p.x_in = (decltype(p.x_in))ldq(lp, 0);
    p.c = (decltype(p.c))ldq(lp, 1);
    p.pos = (decltype(p.pos))ldq(lp, 2);
    p.ada_w = (decltype(p.ada_w))ldq(lp, 3);
    p.ada_b = (decltype(p.ada_b))ldq(lp, 4);
    p.ln_g = (decltype(p.ln_g))ldq(lp, 5);
    p.ln_b = (decltype(p.ln_b))ldq(lp, 6);
    p.w_in = (decltype(p.w_in))ldq(lp, 7);
    p.w_out = (decltype(p.w_out))ldq(lp, 8);
    p.lb_raw = (decltype(p.lb_raw))ldq(lp, 9);
    p.norm_g = (decltype(p.norm_g))ldq(lp, 10);
    p.sinks = (decltype(p.sinks))ldq(lp, 11);
    p.pool_w = (decltype(p.pool_w))ldq(lp, 12);
    p.pool_scale = (decltype(p.pool_scale))ldq(lp, 13);
    p.w_up = (decltype(p.w_up))ldq(lp, 14);
    p.conv_w = (decltype(p.conv_w))ldq(lp, 15);
    p.conv_b = (decltype(p.conv_b))ldq(lp, 16);
    p.w_down = (decltype(p.w_down))ldq(lp, 17);
    p.out = (decltype(p.out))ldq(lp, 18);
    p.wt_in = (decltype(p.wt_in))ldq(lp, 19);
    p.wt_out = (decltype(p.wt_out))ldq(lp, 20);
    p.wt_up = (decltype(p.wt_up))ldq(lp, 21);
    p.wt_down = (decltype(p.wt_down))ldq(lp, 22);
    p.wt_pool = (decltype(p.wt_pool))ldq(lp, 23);
    p.mod = (decltype(p.mod))ldq(lp, 24);
    p.rope = (decltype(p.rope))ldq(lp, 25);
    p.h = (decltype(p.h))ldq(lp, 26);
    p.za = (decltype(p.za))ldq(lp, 27);
    p.L = (decltype(p.L))ldq(lp, 28);
    p.dec = (decltype(p.dec))ldq(lp, 29);
    p.side = (decltype(p.side))ldq(lp, 30);
    return p;
}


__device__ __forceinline__ int otid() { int t = (int)threadIdx.x; asm volatile("" : "+v"(t)); return t; }
__device__ __forceinline__ int obid() { int b = (int)blockIdx.x; asm volatile("" : "+s"(b)); return b; }
__device__ __forceinline__ int ogrid() { int g = (int)gridDim.x; asm volatile("" : "+s"(g)); return g; }
__device__ __forceinline__ float bf2f(bf16_t v) { return __uint_as_float(((unsigned)v) << 16); }
__device__ __forceinline__ unsigned pk2(float lo, float hi) { unsigned r; asm volatile("v_cvt_pk_bf16_f32 %0, %1, %2" : "=v"(r) : "v"(lo), "v"(hi)); return r; }
__device__ __forceinline__ bf16_t f2bf(float f) { return (bf16_t)(pk2(f, 0.f) & 0xffffu); }
__device__ __forceinline__ float fast_sigmoid(float x) { return __builtin_amdgcn_rcpf(1.0f + __expf(-x)); }
__device__ __forceinline__ float silu_f(float x) { return x * fast_sigmoid(x); }
__device__ __forceinline__ f32x4 mfma16(bf16x8 a, bf16x8 b, f32x4 c) { return __builtin_amdgcn_mfma_f32_16x16x32_bf16(a, b, c, 0, 0, 0); }
__device__ __forceinline__ float wave_sum(float v) {
#pragma unroll
    for (int o = 32; o >= 1; o >>= 1) v += __shfl_xor(v, o);
    return v;
}

namespace pg8 {
constexpr int BM = 256, BK = 64, HALF = 128, HTB = HALF * BK * 2, STAGE_BYTES = 8 * HTB, NXCD = 8, WGM = 8;
__host__ __device__ __forceinline__ int lds_byte(int r, int c) { const int st = (r >> 4) * 2 + (c >> 5), rr = r & 15, cc = c & 31, ob = rr * 64 + cc * 2; return st * 1024 + (ob ^ (((ob >> 9) & 1) << 5)); }
__host__ __device__ __forceinline__ void stage_rc(int b, int& R, int& C) { const int st = b / 1024, sb = b % 1024, swz = sb ^ (((sb >> 9) & 1) << 5); R = (st >> 1) * 16 + swz / 64; C = (st & 1) * 32 + (swz % 64) / 2; }
__host__ __device__ __forceinline__ int perm32(int rho) { const int n = rho >> 4, i = rho & 15; return 8 * (i >> 2) + 4 * n + (i & 3); }

struct Unit { int pm, pn; };
struct Gemm { const bf16_t* A; const bf16_t* Bt; int M, N, K; };

struct StaticOrder {
    int nM, nN, nwg, G, c;
    __device__ void init(int M, int N, int G_, int c_) { nM = M / BM; nN = N / BM; nwg = nM * nN; G = G_; c = c_; }
    __device__ bool next(int i, Unit& u) const {
        const long L = (long)i * G + c; if (L >= nwg) return false;
        int wgid = (int)L; { const int q = nwg / NXCD, r = nwg % NXCD, xcd = wgid % NXCD, off = wgid / NXCD; wgid = (xcd < r ? xcd * (q + 1) : r * (q + 1) + (xcd - r) * q) + off; }
        const int nig = WGM * nN, gid = wgid / nig, fm = gid * WGM, gsz = (nM - fm) < WGM ? (nM - fm) : WGM;
        u.pm = fm + ((wgid % nig) % gsz); u.pn = (wgid % nig) / gsz; return true;
    }
    __device__ __forceinline__ void a_ready(const Unit&) const {}
    __device__ __forceinline__ void done(const Unit&) const {}
};
struct PoolOrder {
    int G, c;
    __device__ bool next(int i, Unit& u) const { const int L = i * G + c; if (L >= 512) return false; u.pm = L; u.pn = L >> 7; return true; }
    __device__ __forceinline__ void a_ready(const Unit&) const {}
    __device__ __forceinline__ void done(const Unit&) const {}
};

struct PassOrder {
    StaticOrder S; int pass;
    __device__ bool next(int i, Unit& u) const { return i == 0 ? S.next(pass, u) : false; }
    __device__ __forceinline__ void a_ready(const Unit&) const {}
    __device__ __forceinline__ void done(const Unit&) const {}
};
struct PoolPassOrder {
    int G, c, pass;
    __device__ bool next(int i, Unit& u) const { if (i > 0) return false; const int L = pass * G + c; if (L >= 512) return false; const int g = L & 3, rt = L >> 2; u.pm = g * 128 + rt; u.pn = g; return true; }
    __device__ __forceinline__ void a_ready(const Unit&) const {}
    __device__ __forceinline__ void done(const Unit&) const {}
};

template <class Epi, class Sched>
__device__ __forceinline__ void gemm_phase(LAS unsigned char* lds, const Gemm g, const Sched& S, const Epi& E) {
    const int tid = otid(), wid = __builtin_amdgcn_readfirstlane(tid >> 6), lane = tid & 63, wr = wid >> 2, wc = wid & 3, fr = lane & 15, fq = lane >> 4;
    const int K = g.K, nt = K / BK;
    unsigned voffA[2], voffB[2];
#pragma unroll
    for (int i = 0; i < 2; ++i) { int R, C; stage_rc(tid * 16 + i * 8192, R, C); const int Rb = Epi::PERM ? ((R & ~31) + perm32(R & 31)) : R;
        voffA[i] = (unsigned)(R * K + C) * 2u; voffB[i] = (unsigned)(Rb * K + C) * 2u; }
    const size_t kstep = (size_t)(BK * 2);
    const size_t hstep = (size_t)HALF * K * 2;
    const size_t tstep = 2 * hstep;
    const unsigned ldsw = (unsigned)wid * 1024u;
    const int aoff = lds_byte(wr * 64 + fr, fq * 8), boff = lds_byte(wc * 32 + fr, fq * 8);
#define PG8_SA(b, h) (((b) * 2 + (h)) * HTB)
#define PG8_SB(b, h) ((4 + (b) * 2 + (h)) * HTB)
#define PG8_STAGE(bufoff, gbase, voff) do { _Pragma("unroll") for (int _i = 0; _i < 2; ++_i) \
        __builtin_amdgcn_global_load_lds((const unsigned*)((const char*)(gbase) + (voff)[_i]), (LAS unsigned*)(lds + (bufoff) + ldsw + _i * 8192), 16, 0, 0); } while (0)
#define PG8_LDA(dst, b, h) do { _Pragma("unroll") for (int m = 0; m < 4; ++m) _Pragma("unroll") for (int k = 0; k < 2; ++k) dst[m][k] = *(const LAS bf16x8*)(lds + PG8_SA(b, h) + aoff + m * 2048 + k * 1024); } while (0)
#define PG8_LDB(dst, b, h) do { _Pragma("unroll") for (int n = 0; n < 2; ++n) _Pragma("unroll") for (int k = 0; k < 2; ++k) dst[n][k] = *(const LAS bf16x8*)(lds + PG8_SB(b, h) + boff + n * 2048 + k * 1024); } while (0)
#define PG8_MMA(ai, bj, At, Bt) do { __builtin_amdgcn_s_setprio(1); _Pragma("unroll") for (int m = 0; m < 4; ++m) _Pragma("unroll") for (int n = 0; n < 2; ++n) _Pragma("unroll") for (int k = 0; k < 2; ++k) \
        acc[ai][bj][m][n] = __builtin_amdgcn_mfma_f32_16x16x32_bf16(Bt[n][k], At[m][k], acc[ai][bj][m][n], 0, 0, 0); __builtin_amdgcn_s_setprio(0); } while (0)
#define PG8_WAIT_V(n) asm volatile("s_waitcnt vmcnt(" #n ")" ::: "memory")
#define PG8_WAIT_L(n) asm volatile("s_waitcnt lgkmcnt(" #n ")" ::: "memory")
#define PG8_BAR __builtin_amdgcn_s_barrier()
#define PG8_SCHED __builtin_amdgcn_sched_barrier(0)
    Unit cur, nxt; int ui = 0;
    if (!S.next(0, cur)) return;
    f32x4 acc[2][2][4][2];
#pragma unroll
    for (int a = 0; a < 2; ++a)
#pragma unroll
        for (int b = 0; b < 2; ++b)
#pragma unroll
            for (int m = 0; m < 4; ++m)
#pragma unroll
                for (int n = 0; n < 2; ++n) acc[a][b][m][n] = (f32x4){0.f, 0.f, 0.f, 0.f};
    bf16x8 At[4][2], B0[2][2], B1[2][2];
    const char* cA = (const char*)g.A + (size_t)cur.pm * tstep; const char* cB = (const char*)g.Bt + (size_t)cur.pn * tstep;
    S.a_ready(cur);
    if constexpr (Epi::PREFETCH) E.prefetch(cur, 0, lds, wid, lane);
    PG8_STAGE(PG8_SB(0, 0), cB, voffB); PG8_STAGE(PG8_SA(0, 0), cA, voffA); PG8_STAGE(PG8_SB(0, 1), cB + hstep, voffB); PG8_STAGE(PG8_SA(0, 1), cA + hstep, voffA);
    if (wr == 1) PG8_BAR;
    PG8_WAIT_V(4); PG8_BAR;
    PG8_STAGE(PG8_SB(1, 0), cB + kstep, voffB); PG8_STAGE(PG8_SA(1, 0), cA + kstep, voffA); PG8_STAGE(PG8_SB(1, 1), cB + hstep + kstep, voffB);
    PG8_WAIT_V(6); PG8_BAR;
    for (;;) {
        const bool has_next = S.next(ui + 1, nxt);
        const char* nA = has_next ? (const char*)g.A + (size_t)nxt.pm * tstep : cA; const char* nB = has_next ? (const char*)g.Bt + (size_t)nxt.pn * tstep : cB;
        for (int t = 0; t < nt; t += 2) {
            const bool last = (t == nt - 2);
            const char* a1 = cA + (size_t)(t + 1) * kstep;
            const char* a2 = last ? nA : cA + (size_t)(t + 2) * kstep; const char* b2 = last ? nB : cB + (size_t)(t + 2) * kstep;
            const char* a3 = a2 + kstep; const char* b3 = b2 + kstep;
            if (last && has_next) S.a_ready(nxt);
            PG8_LDB(B0, 0, 0); PG8_SCHED; PG8_LDA(At, 0, 0); PG8_STAGE(PG8_SA(1, 1), a1 + hstep, voffA);
            PG8_WAIT_L(8); PG8_BAR; PG8_WAIT_L(0); PG8_MMA(0, 0, At, B0); PG8_BAR; PG8_SCHED;
            PG8_LDB(B1, 0, 1); PG8_STAGE(PG8_SB(0, 0), b2, voffB);
            PG8_BAR; PG8_WAIT_L(0); PG8_MMA(0, 1, At, B1); PG8_BAR;
            PG8_LDA(At, 0, 1); PG8_STAGE(PG8_SA(0, 0), a2, voffA);
            PG8_BAR; PG8_WAIT_L(0); PG8_MMA(1, 0, At, B0); PG8_BAR; PG8_SCHED;
            PG8_STAGE(PG8_SB(0, 1), b2 + hstep, voffB);
            PG8_WAIT_V(6); PG8_BAR; PG8_MMA(1, 1, At, B1); PG8_BAR;
            PG8_LDB(B0, 1, 0); PG8_SCHED; PG8_LDA(At, 1, 0); PG8_STAGE(PG8_SA(0, 1), a2 + hstep, voffA);
            PG8_WAIT_L(8); PG8_BAR; PG8_WAIT_L(0); PG8_MMA(0, 0, At, B0); PG8_BAR; PG8_SCHED;
            PG8_LDB(B1, 1, 1); PG8_STAGE(PG8_SB(1, 0), b3, voffB);
            PG8_BAR; PG8_WAIT_L(0); PG8_MMA(0, 1, At, B1); PG8_BAR;
            PG8_LDA(At, 1, 1); PG8_STAGE(PG8_SA(1, 0), a3, voffA);
            PG8_BAR; PG8_WAIT_L(0); PG8_MMA(1, 0, At, B0); PG8_BAR; PG8_SCHED;
            PG8_STAGE(PG8_SB(1, 1), b3 + hstep, voffB);
            PG8_WAIT_V(6); PG8_BAR; PG8_MMA(1, 1, At, B1); PG8_BAR;
        }
        if constexpr (Epi::PREFETCH) { E.run(acc, cur, ui, lds, wr, wc, fr, fq); if (has_next) E.prefetch(nxt, ui + 1, lds, wid, lane); }
        else if constexpr (!Epi::AFTER_DRAIN) E(acc, cur, wr, wc, fr, fq);
        if (!has_next) break;
#pragma unroll
        for (int a = 0; a < 2; ++a)
#pragma unroll
            for (int b = 0; b < 2; ++b)
#pragma unroll
                for (int m = 0; m < 4; ++m)
#pragma unroll
                    for (int n = 0; n < 2; ++n) acc[a][b][m][n] = (f32x4){0.f, 0.f, 0.f, 0.f};
        cur = nxt; cA = nA; cB = nB; ++ui;
    }
    PG8_WAIT_V(0);
    if (wr == 0) PG8_BAR;
    PG8_BAR;
    if constexpr (Epi::AFTER_DRAIN) E.fused(acc, cur, wr, wc, fr, fq, lds, wid, lane);
#undef PG8_SA
#undef PG8_SB
#undef PG8_STAGE
#undef PG8_LDA
#undef PG8_LDB
#undef PG8_MMA
#undef PG8_WAIT_V
#undef PG8_WAIT_L
#undef PG8_BAR
#undef PG8_SCHED
}
}

struct EpiStoreBf16 {
    static constexpr bool PERM = true, AFTER_DRAIN = false, PREFETCH = false;
    bf16_t* O; int ldc;
    __device__ __forceinline__ void operator()(const f32x4 (&acc)[2][2][4][2], const pg8::Unit& u, int wr, int wc, int fr, int fq) const {
        const int row0 = u.pm * 256 + wr * 64 + fr, col0 = u.pn * 256 + wc * 32 + 8 * fq;
#pragma unroll
        for (int ai = 0; ai < 2; ++ai)
#pragma unroll
            for (int m = 0; m < 4; ++m) {
                bf16_t* rowp = O + (size_t)(row0 + ai * 128 + m * 16) * ldc + col0;
#pragma unroll
                for (int bj = 0; bj < 2; ++bj) {
                    const f32x4 v0 = acc[ai][bj][m][0], v1 = acc[ai][bj][m][1];
                    u32x4 o; o[0] = pk2(v0[0], v0[1]); o[1] = pk2(v0[2], v0[3]); o[2] = pk2(v1[0], v1[1]); o[3] = pk2(v1[2], v1[3]);
                    *(u32x4*)(rowp + bj * 128) = o;
                }
            }
    }
};
struct LnFuse {
    const float* xin; float* xout; const float* gate; const float* lng; const float* lnb;
    const float* msc; const float* msh; bf16_t* hout;
    unsigned long long* xbuf; unsigned* cnt; unsigned* tmo; unsigned want;
};
template <bool GROUPED> struct EpiResidLn {
    static constexpr bool PERM = false, AFTER_DRAIN = true, PREFETCH = false;
    LnFuse f;
    typedef float f32x2v __attribute__((ext_vector_type(2)));
    __device__ __forceinline__ void half_load(f32x4 (&xi)[4][2][2], int ai, int rowb, int col0) const {
#pragma unroll
        for (int m = 0; m < 4; ++m) {
            const float* xr = f.xin + (size_t)(rowb + ai * 128 + m * 16) * 1024 + col0;
#pragma unroll
            for (int bj = 0; bj < 2; ++bj)
#pragma unroll
                for (int n = 0; n < 2; ++n) xi[m][bj][n] = *(const f32x4*)(xr + bj * 128 + n * 16);
        }
    }
    __device__ __forceinline__ void half_v(f32x4 (&h)[2][4][2], const f32x4 (&xi)[4][2][2], const f32x4 (&gv)[2][2]) const {
#pragma unroll
        for (int m = 0; m < 4; ++m)
#pragma unroll
            for (int bj = 0; bj < 2; ++bj)
#pragma unroll
                for (int n = 0; n < 2; ++n) h[bj][m][n] = xi[m][bj][n] * ALPHA_C + gv[bj][n] * h[bj][m][n];
    }
    __device__ __forceinline__ void half_stats(const f32x4 (&h)[2][4][2], int ai, int wr, int wc, int fr, int fq, LAS f32x2v* P) const {
#pragma unroll
        for (int m = 0; m < 4; ++m) {
            float sm = 0.f;
#pragma unroll
            for (int bj = 0; bj < 2; ++bj)
#pragma unroll
                for (int n = 0; n < 2; ++n) { const f32x4 x = h[bj][m][n]; sm += (x[0] + x[1]) + (x[2] + x[3]); }
            sm += __shfl_xor(sm, 16); sm += __shfl_xor(sm, 32);
            const float mw = sm * (1.0f / 64.0f); float q = 0.f;
#pragma unroll
            for (int bj = 0; bj < 2; ++bj)
#pragma unroll
                for (int n = 0; n < 2; ++n) { const f32x4 d = h[bj][m][n] - mw; q += (d[0] * d[0] + d[1] * d[1]) + (d[2] * d[2] + d[3] * d[3]); }
            q += __shfl_xor(q, 16); q += __shfl_xor(q, 32);
            if (fq == 0) P[(ai * 128 + wr * 64 + m * 16 + fr) * 4 + wc] = (f32x2v){mw, q};
        }
    }
    struct ColPar { f32x4 gg[2][2], bb[2][2], sc[2][2], sh[2][2]; };
    __device__ __forceinline__ void half5(const f32x4 (&h)[2][4][2], const ColPar& cp, bool has_h, int ai, int rt, int col0, int wr, int fr, const LAS f32x2v* S) const {
#pragma unroll
        for (int m = 0; m < 4; ++m) {
            const int r = ai * 128 + wr * 64 + m * 16 + fr; const f32x2v sr = S[r];
            const size_t off = (size_t)(rt * 256 + r) * 1024 + col0;
#pragma unroll
            for (int bj = 0; bj < 2; ++bj)
#pragma unroll
                for (int n = 0; n < 2; ++n) {
                    const int co = bj * 128 + n * 16;
                    const f32x4 y = (h[bj][m][n] - sr.x) * sr.y * cp.gg[bj][n] + cp.bb[bj][n];
                    *(f32x4*)(f.xout + off + co) = y;
                    if (has_h) { const f32x4 hh = y * (cp.sc[bj][n] + 1.0f) + cp.sh[bj][n]; u32x2 o; o[0] = pk2(hh[0], hh[1]); o[1] = pk2(hh[2], hh[3]); *(u32x2*)(f.hout + off + co) = o; }
                }
        }
    }
    __device__ __forceinline__ void fused(f32x4 (&acc)[2][2][4][2], const pg8::Unit& u, int wr, int wc, int fr, int fq, LAS unsigned char* lds, int wid, int lane) const {
        const int rt = GROUPED ? (u.pm & 127) : u.pm, ct = GROUPED ? (u.pm >> 7) : u.pn;
        const int b = rt >> 3;
        const int rowb = rt * 256 + wr * 64 + fr, col0 = ct * 256 + wc * 32 + 4 * fq;
        LAS unsigned char* RA = lds + (wid * 64 + lane) * 16;
        LAS f32x2v* P = (LAS f32x2v*)(lds + 131072);
        LAS f32x2v* S = (LAS f32x2v*)(lds + 139264);
        f32x4 h[2][4][2], xi[4][2][2];
        half_load(xi, 0, rowb, col0);
        f32x4 gv[2][2];
        { const float* gp = f.gate + (size_t)b * 6144 + col0;
#pragma unroll
          for (int bj = 0; bj < 2; ++bj)
#pragma unroll
              for (int n = 0; n < 2; ++n) gv[bj][n] = *(const f32x4*)(gp + bj * 128 + n * 16); }
#pragma unroll
        for (int bj = 0; bj < 2; ++bj)
#pragma unroll
            for (int m = 0; m < 4; ++m)
#pragma unroll
                for (int n = 0; n < 2; ++n) { *(LAS f32x4*)(RA + ((bj * 4 + m) * 2 + n) * 8192) = acc[1][bj][m][n]; h[bj][m][n] = acc[0][bj][m][n]; }
        asm volatile("" ::: "memory");
        half_v(h, xi, gv);
        asm volatile("" ::: "memory");
        half_load(xi, 1, rowb, col0);
        half_stats(h, 0, wr, wc, fr, fq, P);
#pragma unroll
        for (int bj = 0; bj < 2; ++bj)
#pragma unroll
            for (int m = 0; m < 4; ++m)
#pragma unroll
                for (int n = 0; n < 2; ++n) { LAS f32x4* sp = (LAS f32x4*)(RA + ((bj * 4 + m) * 2 + n) * 8192); const f32x4 t = *sp; *sp = h[bj][m][n]; h[bj][m][n] = t; }
        asm volatile("" ::: "memory");
        half_v(h, xi, gv);
        half_stats(h, 1, wr, wc, fr, fq, P);
        ColPar cp; const bool has_h = f.msc != nullptr;
        {
            const float* mscp = has_h ? f.msc + (size_t)b * 6144 + col0 : f.lng + col0;
            const float* mshp = has_h ? f.msh + (size_t)b * 6144 + col0 : f.lng + col0;
#pragma unroll
            for (int bj = 0; bj < 2; ++bj)
#pragma unroll
                for (int n = 0; n < 2; ++n) { const int co = bj * 128 + n * 16;
                    cp.gg[bj][n] = *(const f32x4*)(f.lng + col0 + co); cp.bb[bj][n] = *(const f32x4*)(f.lnb + col0 + co);
                    cp.sc[bj][n] = *(const f32x4*)(mscp + co); cp.sh[bj][n] = *(const f32x4*)(mshp + co); }
        }
        asm volatile("s_waitcnt lgkmcnt(0)" ::: "memory"); __builtin_amdgcn_s_barrier(); asm volatile("" ::: "memory");
        const int row = wid * 32 + (lane & 31);
        if (lane < 32) {
            const f32x2v a = P[row * 4 + 0], bq = P[row * 4 + 1], c = P[row * 4 + 2], d = P[row * 4 + 3];
            const float mt = (a.x + bq.x + c.x + d.x) * 0.25f;
            const float da = a.x - mt, db = bq.x - mt, dc = c.x - mt, dd = d.x - mt;
            const float m2 = (a.y + bq.y) + (c.y + d.y) + 64.0f * ((da * da + db * db) + (dc * dc + dd * dd));
            unsigned long long* slot = f.xbuf + ((size_t)(rt * 256 + row) * 4 + ct);
            __hip_atomic_store(slot, ((unsigned long long)__float_as_uint(m2) << 32) | __float_as_uint(mt), __ATOMIC_RELAXED, __HIP_MEMORY_SCOPE_AGENT);
        }
        asm volatile("s_waitcnt vmcnt(0)" ::: "memory");
        if (lane == 0) __hip_atomic_fetch_add(f.cnt + 64 * rt, 1u, __ATOMIC_RELAXED, __HIP_MEMORY_SCOPE_AGENT);
        if (wid == 0) {
            unsigned sp = 0u;
            while ((unsigned)__builtin_amdgcn_readfirstlane(__hip_atomic_load(f.cnt + 64 * rt, __ATOMIC_RELAXED, __HIP_MEMORY_SCOPE_AGENT)) < f.want) {
                __builtin_amdgcn_s_sleep(2);
                if (++sp > (1u << 22)) { if (lane == 0) __hip_atomic_store(f.tmo, 1u, __ATOMIC_RELAXED, __HIP_MEMORY_SCOPE_AGENT); break; }
            }
            __builtin_amdgcn_fence(__ATOMIC_ACQUIRE, "agent");
        }
        asm volatile("s_waitcnt vmcnt(0) lgkmcnt(0)" ::: "memory"); __builtin_amdgcn_s_barrier(); asm volatile("" ::: "memory");
        if (lane < 32) {
            const unsigned long long* slot = f.xbuf + (size_t)(rt * 256 + row) * 4; float mt[4], m2[4]; float ms = 0.f;
#pragma unroll
            for (int t = 0; t < 4; ++t) { const unsigned long long w = __hip_atomic_load(slot + t, __ATOMIC_RELAXED, __HIP_MEMORY_SCOPE_AGENT); mt[t] = __uint_as_float((unsigned)w); m2[t] = __uint_as_float((unsigned)(w >> 32)); ms += mt[t]; }
            const float mean = ms * 0.25f; float q = 0.f;
#pragma unroll
            for (int t = 0; t < 4; ++t) { const float dm = mt[t] - mean; q += m2[t] + 256.0f * dm * dm; }
            S[row] = (f32x2v){mean, 1.0f / sqrtf(q * (1.0f / 1024.0f) + 1e-5f)};
        }
        asm volatile("s_waitcnt lgkmcnt(0)" ::: "memory"); __builtin_amdgcn_s_barrier(); asm volatile("" ::: "memory");
        half5(h, cp, has_h, 1, rt, col0, wr, fr, S);
        asm volatile("" ::: "memory");
#pragma unroll
        for (int bj = 0; bj < 2; ++bj)
#pragma unroll
            for (int m = 0; m < 4; ++m)
#pragma unroll
                for (int n = 0; n < 2; ++n) h[bj][m][n] = *(const LAS f32x4*)(RA + ((bj * 4 + m) * 2 + n) * 8192);
        asm volatile("" ::: "memory");
        half5(h, cp, has_h, 0, rt, col0, wr, fr, S);
        asm volatile("s_waitcnt lgkmcnt(0)" ::: "memory"); __builtin_amdgcn_s_barrier(); asm volatile("" ::: "memory");
    }
};
struct EpiConvGate {
    static constexpr bool PERM = true, AFTER_DRAIN = false, PREFETCH = true;
    bf16_t* a; float* side; const float* cw; const float* cb;
    static constexpr int PAR_OFF = 131072;
    __device__ __forceinline__ void prefetch(const pg8::Unit& u, int ui, LAS unsigned char* lds, int wid, int lane) const {
        if (wid == 0) {
            const int fcol = u.pn * 128 + (lane & 31) * 4, hi = lane >> 5;
            const float* s0 = (hi ? cw + 2816 : cw) + fcol;
            const float* s1 = (hi ? cb : cw + 5632) + fcol;
            LAS unsigned char* dst = lds + PAR_OFF + (ui & 1) * 2048;
            __builtin_amdgcn_global_load_lds((const unsigned*)s0, (LAS unsigned*)dst, 16, 0, 0);
            __builtin_amdgcn_global_load_lds((const unsigned*)s1, (LAS unsigned*)(dst + 1024), 16, 0, 0);
        }
    }
    __device__ __forceinline__ void run(const f32x4 (&acc)[2][2][4][2], const pg8::Unit& u, int ui, LAS unsigned char* lds, int wr, int wc, int fr, int fq) const {
        const LAS float* par = (const LAS float*)(lds + PAR_OFF + (ui & 1) * 2048);
        const int lane = fr + 16 * fq;
        const int src1 = (lane & 48) | ((fr + 15) & 15), src2 = (lane & 48) | ((fr + 14) & 15);
        const int f0 = u.pn * 128 + wc * 32 + 8 * fq;
#pragma unroll
        for (int n = 0; n < 2; ++n) {
            const int fb = f0 + 4 * n;
            const int fl = wc * 32 + 8 * fq + 4 * n;
            const f32x4 w0 = *(const LAS f32x4*)(par + fl), w1 = *(const LAS f32x4*)(par + 128 + fl), w2 = *(const LAS f32x4*)(par + 256 + fl), bb = *(const LAS f32x4*)(par + 384 + fl);
#pragma unroll
            for (int ai = 0; ai < 2; ++ai) {
                const int strip = u.pm * 4 + ai * 2 + wr;
                float* sd = side + (size_t)strip * (6 * 2816) + fb;
                if (fr < 2) { *(f32x4*)(sd + fr * 2816) = acc[ai][0][0][n]; *(f32x4*)(sd + (2 + fr) * 2816) = acc[ai][1][0][n]; }
                if (fr >= 14) { *(f32x4*)(sd + (4 + fr - 14) * 2816) = acc[ai][0][3][n]; }
                f32x4 s1p = (f32x4){0.f, 0.f, 0.f, 0.f}, s2p = s1p;
#pragma unroll
                for (int m = 0; m < 4; ++m) {
                    const f32x4 uu = acc[ai][0][m][n];
                    f32x4 s1, s2;
#pragma unroll
                    for (int e = 0; e < 4; ++e) { s1[e] = __shfl(uu[e], src1); s2[e] = __shfl(uu[e], src2); }
                    const f32x4 p1 = fr >= 1 ? s1 : s1p, p2 = fr >= 2 ? s2 : s2p;
                    const f32x4 uc = bb + w0 * p2 + w1 * p1 + w2 * uu;
                    const f32x4 vv = acc[ai][1][m][n];
                    f32x4 r;
#pragma unroll
                    for (int e = 0; e < 4; ++e) r[e] = silu_f(uc[e]) * vv[e];
                    s1p = s1; s2p = s2;
                    if (!(m == 0 && fr < 2)) {
                        u32x2 o; o[0] = pk2(r[0], r[1]); o[1] = pk2(r[2], r[3]);
                        *(u32x2*)(a + (size_t)(u.pm * 256 + ai * 128 + wr * 64 + m * 16 + fr) * FF + fb) = o;
                    }
                }
            }
        }
    }
};

struct TrDesc { const float* src; bf16_t* dst; const float* scale; int ldS, K, k0, n0, col0; };
__device__ __forceinline__ TrDesc tr_decode(const Params& p, int t) {
    TrDesc d; d.scale = nullptr;
    if (t < 704) { const int e = t / 352, r = t % 352, kt = r / 22, nt = r % 22;
        d.src = p.w_in + (size_t)e * 1024 * 2816; d.ldS = 2816; d.K = 1024; d.dst = p.wt_in + (size_t)e * 2816 * 1024; d.k0 = kt * 64; d.n0 = nt * 128; d.col0 = nt * 128; }
    else if (t < 960) { const int tt = t - 704, e = tt / 128, r = tt % 128, kt = r / 8, nt = r % 8;
        d.src = p.w_out + (size_t)e * 1024 * 1024; d.ldS = 1024; d.K = 1024; d.dst = p.wt_out + (size_t)e * 1024 * 1024; d.k0 = kt * 64; d.n0 = nt * 128; d.col0 = nt * 128; }
    else if (t < 3776) { const int tt = t - 960, l = tt / 704, r = tt % 704, kt = r / 44, nt = r % 44;
        const int j0 = nt * 128, pn = j0 >> 8, half = (j0 >> 7) & 1;
        d.src = p.w_up + (size_t)l * 1024 * 5632; d.ldS = 5632; d.K = 1024; d.dst = p.wt_up + (size_t)l * 5632 * 1024; d.k0 = kt * 64; d.n0 = j0; d.col0 = half * 2816 + pn * 128; }
    else if (t < 5184) { const int tt = t - 3776, l = tt / 352, r = tt % 352, kt = r / 8, nt = r % 8;
        d.src = p.w_down + (size_t)l * 2816 * 1024; d.ldS = 1024; d.K = 2816; d.dst = p.wt_down + (size_t)l * 1024 * 2816; d.k0 = kt * 64; d.n0 = nt * 128; d.col0 = nt * 128; }
    else { const int tt = t - 5184, og = tt / 8, r = tt % 8, kt = r / 2, nt = r % 2;
        d.src = p.pool_w + (size_t)og * 65536; d.ldS = 256; d.K = 256; d.dst = p.wt_pool + (size_t)og * 65536; d.k0 = kt * 64; d.n0 = nt * 128; d.col0 = nt * 128;
        d.scale = p.pool_scale + (og >> 2) * 1024 + (og & 3) * 256; }
    return d;
}
__device__ __forceinline__ void tr_load(const TrDesc& d, int tid, f32x4 (&v)[4]) {
    const int r = tid >> 5, c4 = (tid & 31) * 4;
#pragma unroll
    for (int i = 0; i < 4; ++i) v[i] = *(const f32x4*)(d.src + (size_t)(d.k0 + r + 16 * i) * d.ldS + d.col0 + c4);
}
__device__ __forceinline__ void phase_prep(const Params& p, unsigned char* smem) {
    const int tid = otid(), lane = tid & 63, wid = tid >> 6;
    {
        float* cact = (float*)smem;
        float* red = cact + 16384;
        for (int i = tid; i < 16384; i += 512) { const float cv = p.c[i]; cact[i] = silu_f(cv); }
        __syncthreads();
        for (int tile = obid(); tile < 192; tile += ogrid()) {
            const int col = tile * 128 + lane, l = col / 6144, j = col % 6144;
            const float* w = p.ada_w + (size_t)l * 1024 * 6144 + j;
            const int k0 = wid * 128;
            float acc0[16], acc1[16];
#pragma unroll
            for (int b = 0; b < 16; ++b) { acc0[b] = 0.f; acc1[b] = 0.f; }
            for (int kk = 0; kk < 128; kk += 8) {
                float w0[8], w1[8];
#pragma unroll
                for (int q = 0; q < 8; ++q) { w0[q] = w[(size_t)(k0 + kk + q) * 6144]; w1[q] = w[(size_t)(k0 + kk + q) * 6144 + 64]; }
#pragma unroll
                for (int q4 = 0; q4 < 2; ++q4)
#pragma unroll
                    for (int b = 0; b < 16; ++b) { const f32x4 cv = *(const f32x4*)(cact + b * 1024 + k0 + kk + 4 * q4);
                        acc0[b] += cv[0] * w0[4 * q4] + cv[1] * w0[4 * q4 + 1] + cv[2] * w0[4 * q4 + 2] + cv[3] * w0[4 * q4 + 3];
                        acc1[b] += cv[0] * w1[4 * q4] + cv[1] * w1[4 * q4 + 1] + cv[2] * w1[4 * q4 + 2] + cv[3] * w1[4 * q4 + 3]; }
            }
#pragma unroll
            for (int b = 0; b < 16; ++b) { red[(wid * 16 + b) * 128 + lane] = acc0[b]; red[(wid * 16 + b) * 128 + 64 + lane] = acc1[b]; }
            __syncthreads();
#pragma unroll
            for (int i = 0; i < 4; ++i) { const int o = tid + 512 * i, b = o >> 7, cl = o & 127;
                float sm = 0.f;
#pragma unroll
                for (int w8 = 0; w8 < 8; ++w8) sm += red[(w8 * 16 + b) * 128 + cl];
                const int cc = tile * 128 + cl, ll = cc / 6144, jj = cc % 6144;
                p.mod[((size_t)ll * 16 + b) * 6144 + jj] = sm + p.ada_b[ll * 6144 + jj]; }
            __syncthreads();
        }
    }
    {
        float* tile = (float*)smem;
        const int gstep = ogrid();
        int t = obid();
        f32x4 v[4];
        TrDesc d = tr_decode(p, t < 5248 ? t : 0);
        if (t < 5248) tr_load(d, tid, v);
        for (; t < 5248; t += gstep) {
            { const int r = tid >> 5, c4 = (tid & 31) * 4;
#pragma unroll
              for (int i = 0; i < 4; ++i) { float* tp = tile + (r + 16 * i) * 129 + c4; tp[0] = v[i][0]; tp[1] = v[i][1]; tp[2] = v[i][2]; tp[3] = v[i][3]; } }
            __syncthreads();
            const TrDesc dc = d;
            if (t + gstep < 5248) { d = tr_decode(p, t + gstep); tr_load(d, tid, v); }
#pragma unroll
            for (int i = 0; i < 2; ++i) {
                const int o = tid + 512 * i, n = o >> 3, k8 = (o & 7) * 8; const float sc = dc.scale ? dc.scale[dc.n0 + n] : 1.0f;
                float w[8];
#pragma unroll
                for (int e2 = 0; e2 < 8; ++e2) w[e2] = tile[(k8 + e2) * 129 + n] * sc;
                u32x4 ov; ov[0] = pk2(w[0], w[1]); ov[1] = pk2(w[2], w[3]); ov[2] = pk2(w[4], w[5]); ov[3] = pk2(w[6], w[7]);
                if (dc.scale) {
                    const int dd = dc.n0 + n, kk = dc.k0 + k8;
                    *(u32x4*)(dc.dst + ((size_t)(((dd >> 4) * 8 + (kk >> 5)) * 64 + ((kk & 31) >> 3) * 16 + (dd & 15))) * 8) = ov;
                } else
                *(u32x4*)(dc.dst + (size_t)(dc.n0 + n) * dc.K + dc.k0 + k8) = ov;
            }
            __syncthreads();
        }
    }
    for (int idx = obid() * 512 + tid; idx < MTOK * 8; idx += ogrid() * 512) {
        const int row = idx >> 3, i = idx & 7;
        const float invf = i == 0 ? 1.0f : i == 1 ? 0.1939227432012558f : i == 2 ? 0.03760603070259094f : i == 3 ? 0.007292664609849453f
                         : i == 4 ? 0.0014142135623842478f : i == 5 ? 0.00027424818836152554f : i == 6 ? 5.3182957344688475e-05f : 1.0313385246263351e-05f;
        const float ang = (float)p.pos[row] * invf;
        const float nrev = rintf(ang * 0.15915494309189535f);
        float rr = fmaf(-nrev, 6.2831854820251465f, ang); rr = fmaf(-nrev, -1.7484556025237907e-07f, rr);
        p.rope[row * 16 + i] = __cosf(rr);
        p.rope[row * 16 + 8 + i] = __sinf(rr);
    }
}

__device__ __forceinline__ void phase_h0(const Params& p) {
    const int gt = obid() * 512 + otid(), gs = ogrid() * 512;
    for (int i0 = gt; i0 < MTOK * 256; i0 += 4 * gs) {
        f32x4 x[4];
#pragma unroll
        for (int j = 0; j < 4; ++j) { const int i4 = i0 + j * gs; if (i4 < MTOK * 256) x[j] = *(const f32x4*)(p.x_in + (size_t)i4 * 4); }
#pragma unroll
        for (int j = 0; j < 4; ++j) {
            const int i4 = i0 + j * gs;
            if (i4 < MTOK * 256) {
                const int row = i4 >> 8, col = (i4 & 255) * 4, b = row >> 11;
                const float* mp = p.mod + (size_t)b * 6144;
                const f32x4 sh = *(const f32x4*)(mp + col), sc = *(const f32x4*)(mp + 1024 + col);
                const f32x4 hh = x[j] * (sc + 1.0f) + sh;
                u32x2 o; o[0] = pk2(hh[0], hh[1]); o[1] = pk2(hh[2], hh[3]);
                *(u32x2*)(p.h + (size_t)i4 * 4) = o;
            }
        }
    }
}

__device__ __forceinline__ void phase_ln(const Params& p, int l, int sub) {
    const int lane = otid() & 63, wid = otid() >> 6;
    const float* g = p.ln_g + (l * 2 + sub) * 1024; const float* bt = p.ln_b + (l * 2 + sub) * 1024;
    const bool has_next = !(l == 3 && sub == 1);
    const int nl = sub == 0 ? l : l + 1, sc_off = sub == 0 ? 4096 : 1024, sh_off = sub == 0 ? 3072 : 0;
    for (int row = obid() * 8 + wid; row < MTOK; row += ogrid() * 8) {
        float* xr = p.out + (size_t)row * 1024;
        f32x4 v[4];
#pragma unroll
        for (int i = 0; i < 4; ++i) v[i] = *(const f32x4*)(xr + i * 256 + lane * 4);
        float s = 0.f;
#pragma unroll
        for (int i = 0; i < 4; ++i) s += v[i][0] + v[i][1] + v[i][2] + v[i][3];
        s = wave_sum(s); const float mu = s * (1.0f / 1024.0f);
        float q = 0.f;
#pragma unroll
        for (int i = 0; i < 4; ++i) { const f32x4 d = v[i] - mu; q += d[0] * d[0] + d[1] * d[1] + d[2] * d[2] + d[3] * d[3]; }
        q = wave_sum(q); const float rstd = rsqrtf(q * (1.0f / 1024.0f) + 1e-5f);
        const int b = row >> 11;
        const float* mp = p.mod + ((size_t)nl * 16 + b) * 6144;
#pragma unroll
        for (int i = 0; i < 4; ++i) {
            const int col = i * 256 + lane * 4;
            const f32x4 gg = *(const f32x4*)(g + col), bb = *(const f32x4*)(bt + col);
            const f32x4 y = (v[i] - mu) * rstd * gg + bb;
            *(f32x4*)(xr + col) = y;
            if (has_next) {
                const f32x4 sc = *(const f32x4*)(mp + sc_off + col), sh = *(const f32x4*)(mp + sh_off + col);
                const f32x4 hh = y * (sc + 1.0f) + sh;
                u32x2 o; o[0] = pk2(hh[0], hh[1]); o[1] = pk2(hh[2], hh[3]);
                *(u32x2*)(p.h + (size_t)row * 1024 + col) = o;
            }
        }
    }
}

__device__ __forceinline__ float lb_of(const Params& p, int e, int kidx) {
    if (e == 0) return 0.f;
    const float r0 = p.lb_raw[kidx], r1 = p.lb_raw[512 + kidx];
    return 1.0f / (1.0f + __expf(r0 - r1));
}

__device__ __forceinline__ void phase_hgrnA(const Params& p, int e, unsigned char* smem) {
    const int tid = otid(), k = tid & 127, seg = tid >> 7, lane = tid & 63, wid = tid >> 6, fr = lane & 15, fq = lane >> 4;
    float* segsum = (float*)smem;
    bf16_t* kT = (bf16_t*)(smem + 2048);
    bf16_t* vT = kT + 128 * 72;
    const int gstep = ogrid();
    float lb4[4];
#pragma unroll
    for (int q = 0; q < 4; ++q) lb4[q] = lb_of(p, e, q * 128 + k);
    unsigned fzr[16], vr[16];
    { const int item = obid();
      if (item < 2048) { const int c = item & 31, bh = item >> 5, hh = bh & 3, b = bh >> 2;
          const bf16_t* zf = p.za + ((size_t)b * 2048 + c * 64 + seg * 16) * ZW + 512 + hh * 128 + k;
#pragma unroll
          for (int i = 0; i < 16; ++i) { fzr[i] = zf[(size_t)i * ZW]; vr[i] = zf[(size_t)i * ZW + 512]; } } }
    for (int item = obid(); item < 2048; item += gstep) {
        const int c = item & 31, bh = item >> 5, hh = bh & 3, b = bh >> 2;
        const float lb = hh == 0 ? lb4[0] : hh == 1 ? lb4[1] : hh == 2 ? lb4[2] : lb4[3], oml = 1.0f - lb;
        float kk[16], bb[16]; float run = 0.f;
#pragma unroll
        for (int i = 0; i < 16; ++i) {
            float fz = __uint_as_float(fzr[i] << 16); fz = fminf(fmaxf(fz, -30.f), 30.f);
            const float em = __expf(-fz), sg = __builtin_amdgcn_rcpf(1.0f + em);
            run += __logf(lb + oml * sg); bb[i] = run; kk[i] = oml * em * sg;
        }
        unsigned vraw[8];
#pragma unroll
        for (int i = 0; i < 8; ++i) vraw[i] = vr[2 * i] | (vr[2 * i + 1] << 16);
        { const int nitem = item + gstep;
          if (nitem < 2048) { const int c2 = nitem & 31, bh2 = nitem >> 5, hh2 = bh2 & 3, b2 = bh2 >> 2;
              const bf16_t* zf = p.za + ((size_t)b2 * 2048 + c2 * 64 + seg * 16) * ZW + 512 + hh2 * 128 + k;
#pragma unroll
              for (int i = 0; i < 16; ++i) { fzr[i] = zf[(size_t)i * ZW]; vr[i] = zf[(size_t)i * ZW + 512]; } } }
        segsum[seg * 128 + k] = run;
        __syncthreads();
        float off = 0.f, tot = 0.f;
#pragma unroll
        for (int s = 0; s < 4; ++s) { const float v = segsum[s * 128 + k]; tot += v; if (s < seg) off += v; }
        unsigned kp[8];
#pragma unroll
        for (int i = 0; i < 8; ++i) kp[i] = pk2(kk[2 * i] * __expf(tot - off - bb[2 * i]), kk[2 * i + 1] * __expf(tot - off - bb[2 * i + 1]));
        *(u32x4*)(kT + k * 72 + seg * 16) = (u32x4){kp[0], kp[1], kp[2], kp[3]};
        *(u32x4*)(kT + k * 72 + seg * 16 + 8) = (u32x4){kp[4], kp[5], kp[6], kp[7]};
        *(u32x4*)(vT + k * 72 + seg * 16) = (u32x4){vraw[0], vraw[1], vraw[2], vraw[3]};
        *(u32x4*)(vT + k * 72 + seg * 16 + 8) = (u32x4){vraw[4], vraw[5], vraw[6], vraw[7]};
        if (seg == 0) p.dec[(size_t)item * 128 + k] = __expf(tot);
        __syncthreads();
        f32x4 acc[8];
#pragma unroll
        for (int n = 0; n < 8; ++n) acc[n] = (f32x4){0.f, 0.f, 0.f, 0.f};
#pragma unroll
        for (int ks = 0; ks < 2; ++ks) {
            const bf16x8 a = *(const bf16x8*)(kT + (16 * wid + fr) * 72 + ks * 32 + fq * 8);
#pragma unroll
            for (int n = 0; n < 8; ++n) { const bf16x8 bq = *(const bf16x8*)(vT + (16 * n + fr) * 72 + ks * 32 + fq * 8); acc[n] = mfma16(a, bq, acc[n]); }
        }
        bf16_t* Lp = (bf16_t*)p.L + (size_t)item * 16384;
#pragma unroll
        for (int n = 0; n < 8; ++n) { u32x2 o; o[0] = pk2(acc[n][0], acc[n][1]); o[1] = pk2(acc[n][2], acc[n][3]);
            *(u32x2*)(Lp + (16 * n + fr) * 128 + 16 * wid + 4 * fq) = o; }
        __syncthreads();
    }
}

__device__ __forceinline__ f32x4 bf4_to_f32(u32x2 w) { return (f32x4){__uint_as_float(w[0] << 16), __uint_as_float(w[0] & 0xffff0000u), __uint_as_float(w[1] << 16), __uint_as_float(w[1] & 0xffff0000u)}; }
__device__ __forceinline__ void phase_hgrnB(const Params& p) {
    const int gs = ogrid() * 512;
    for (int task = obid() * 512 + otid(); task < 64 * 4096; task += 2 * gs) {
        const int task2 = task + gs; const bool two = task2 < 64 * 4096;
        const int bh = task >> 12, e4 = task & 4095, bh2 = two ? (task2 >> 12) : bh, e42 = two ? (task2 & 4095) : e4;
        bf16_t* base = (bf16_t*)p.L + (size_t)bh * 32 * 16384 + e4 * 4;
        bf16_t* base2 = (bf16_t*)p.L + (size_t)bh2 * 32 * 16384 + e42 * 4;
        const float* d = p.dec + (size_t)bh * 32 * 128 + ((e4 * 4) & 127);
        const float* d2 = p.dec + (size_t)bh2 * 32 * 128 + ((e42 * 4) & 127);
        float zf = 0.f; asm volatile("" : "+v"(zf));
        f32x4 S = (f32x4){zf, zf, zf, zf}, S2 = S;
#pragma unroll
        for (int c0 = 0; c0 < 32; c0 += 8) {
            u32x2 tmp[8], tmp2[8]; f32x4 dd[8], dd2[8];
#pragma unroll
            for (int c = 0; c < 8; ++c) { tmp[c] = *(const u32x2*)(base + (size_t)(c0 + c) * 16384); tmp2[c] = *(const u32x2*)(base2 + (size_t)(c0 + c) * 16384);
                dd[c] = *(const f32x4*)(d + (c0 + c) * 128); dd2[c] = *(const f32x4*)(d2 + (c0 + c) * 128); }
#pragma unroll
            for (int c = 0; c < 8; ++c) {
                { u32x2 o; o[0] = pk2(S[0], S[1]); o[1] = pk2(S[2], S[3]); *(u32x2*)(base + (size_t)(c0 + c) * 16384) = o; }
                S = dd[c] * S + bf4_to_f32(tmp[c]);
                if (two) { u32x2 o; o[0] = pk2(S2[0], S2[1]); o[1] = pk2(S2[2], S2[3]); *(u32x2*)(base2 + (size_t)(c0 + c) * 16384) = o;
                    S2 = dd2[c] * S2 + bf4_to_f32(tmp2[c]); }
            }
        }
    }
}

__device__ __forceinline__ void phase_hgrnC(const Params& p, int e, unsigned char* smem) {
    const int tid = otid(), k = tid & 127, seg = tid >> 7, lane = tid & 63, wid = tid >> 6, fr = lane & 15, fq = lane >> 4;
    float* segsum = (float*)smem;
    float* ssq = (float*)(smem + 2048);
    bf16_t* Qe = (bf16_t*)(smem + 4096);
    bf16_t* Qi = Qe + 64 * 136;
    bf16_t* Sb = Qi + 64 * 136;
    bf16_t* Kh = Sb + 128 * 136;
    bf16_t* vT = Kh + 160 * 136;
    bf16_t* At = vT + 128 * 72;
    const int gstep = ogrid();
    float lb4[4];
#pragma unroll
    for (int q = 0; q < 4; ++q) lb4[q] = lb_of(p, e, q * 128 + k);
    f32x4 ng4[4];
#pragma unroll
    for (int n = 0; n < 4; ++n) ng4[n] = *(const f32x4*)(p.norm_g + e * 128 + 16 * ((wid & 1) * 4 + n) + 4 * fq);
    unsigned qr[16], fzr[16], vr[16];
    { const int item = obid();
      if (item < 2048) { const int c = item & 31, bh = item >> 5, hh = bh & 3, b = bh >> 2;
          const bf16_t* zq = p.za + ((size_t)b * 2048 + c * 64 + seg * 16) * ZW + hh * 128 + k;
#pragma unroll
          for (int i = 0; i < 16; ++i) { qr[i] = zq[(size_t)i * ZW]; fzr[i] = zq[(size_t)i * ZW + 512]; vr[i] = zq[(size_t)i * ZW + 1024]; } } }
    for (int item = obid(); item < 2048; item += gstep) {
        const int c = item & 31, bh = item >> 5, hh = bh & 3, b = bh >> 2;
        const size_t rowc = (size_t)b * 2048 + c * 64;
        const float lb = hh == 0 ? lb4[0] : hh == 1 ? lb4[1] : hh == 2 ? lb4[2] : lb4[3], oml = 1.0f - lb;
        float kk[16], bb[16], qq[16]; float run = 0.f;
#pragma unroll
        for (int i = 0; i < 16; ++i) {
            float fz = __uint_as_float(fzr[i] << 16); fz = fminf(fmaxf(fz, -30.f), 30.f);
            const float em = __expf(-fz), sg = __builtin_amdgcn_rcpf(1.0f + em);
            run += __logf(lb + oml * sg); bb[i] = run; kk[i] = oml * em * sg;
            qq[i] = __uint_as_float(qr[i] << 16);
        }
        unsigned vraw[8];
#pragma unroll
        for (int i = 0; i < 8; ++i) vraw[i] = vr[2 * i] | (vr[2 * i + 1] << 16);
        { const int nitem = item + gstep;
          if (nitem < 2048) { const int c2 = nitem & 31, bh2 = nitem >> 5, hh2 = bh2 & 3, b2 = bh2 >> 2;
              const bf16_t* zq = p.za + ((size_t)b2 * 2048 + c2 * 64 + seg * 16) * ZW + hh2 * 128 + k;
#pragma unroll
              for (int i = 0; i < 16; ++i) { qr[i] = zq[(size_t)i * ZW]; fzr[i] = zq[(size_t)i * ZW + 512]; vr[i] = zq[(size_t)i * ZW + 1024]; } } }
        segsum[seg * 128 + k] = run;
        for (int i = tid; i < 64 * 72 / 2; i += 512) ((unsigned*)At)[i] = 0u;
        { const bf16_t* Sp = (const bf16_t*)p.L + (size_t)item * 16384;
#pragma unroll
          for (int i = 0; i < 4; ++i) { const int i8 = tid + 512 * i, v = i8 >> 4, k8 = (i8 & 15) * 8; *(u32x4*)(Sb + v * 136 + k8) = *(const u32x4*)(Sp + (size_t)i8 * 8); } }
        __syncthreads();
        float ss[4];
#pragma unroll
        for (int s = 0; s < 4; ++s) ss[s] = segsum[s * 128 + k];
        float off = 0.f;
#pragma unroll
        for (int s = 0; s < 4; ++s) if (s < seg) off += ss[s];
        const float eoff = __expf(off);
#pragma unroll
        for (int i = 0; i < 16; ++i) {
            const int t = seg * 16 + i;
            const float qi = qq[i] * __expf(bb[i]);
            Qi[t * 136 + k] = f2bf(qi);
            Qe[t * 136 + k] = f2bf(qi * eoff);
        }
        { const float ssg = seg == 0 ? ss[0] : seg == 1 ? ss[1] : seg == 2 ? ss[2] : ss[3];
          { const int base = 16 * (seg * (seg + 1) / 2);
#pragma unroll
            for (int j = 0; j < 16; ++j) Kh[(base + seg * 16 + j) * 136 + k] = f2bf(kk[j] * __expf(fminf(-bb[j], 80.f))); }
          if (seg < 3) {
#pragma unroll
              for (int j = 0; j < 16; ++j) kk[j] *= __expf(ssg - bb[j]);
              float racc = 0.f;
#pragma unroll
              for (int i = 1; i < 4; ++i) {
                  if (i > seg) {
                      const int base = 16 * (i * (i + 1) / 2);
                      const float fac = __expf(racc);
#pragma unroll
                      for (int j = 0; j < 16; ++j) Kh[(base + seg * 16 + j) * 136 + k] = f2bf(kk[j] * fac);
                      racc += ss[i];
                  }
              }
          } }
        *(u32x4*)(vT + k * 72 + seg * 16) = (u32x4){vraw[0], vraw[1], vraw[2], vraw[3]};
        *(u32x4*)(vT + k * 72 + seg * 16 + 8) = (u32x4){vraw[4], vraw[5], vraw[6], vraw[7]};
        __syncthreads();
        const int mt = wid >> 1, ntb = (wid & 1) * 4;
        u32x2 agr[4];
#pragma unroll
        for (int n = 0; n < 4; ++n) agr[n] = *(const u32x2*)(p.za + (rowc + 16 * mt + fr) * ZW + 1536 + hh * 128 + 16 * (ntb + n) + 4 * fq);
        for (int tl = wid; tl < 10; tl += 8) {
            const int i = tl < 1 ? 0 : (tl < 3 ? 1 : (tl < 6 ? 2 : 3)), j = tl - i * (i + 1) / 2, base = 16 * (i * (i + 1) / 2);
            f32x4 a4 = (f32x4){0.f, 0.f, 0.f, 0.f};
#pragma unroll
            for (int ks = 0; ks < 4; ++ks) {
                const bf16x8 a = *(const bf16x8*)(Qi + (16 * i + fr) * 136 + ks * 32 + fq * 8);
                const bf16x8 bq = *(const bf16x8*)(Kh + (base + 16 * j + fr) * 136 + ks * 32 + fq * 8);
                a4 = mfma16(a, bq, a4);
            }
#pragma unroll
            for (int jj = 0; jj < 4; ++jj) { const int tl_ = 4 * fq + jj; float v = a4[jj]; if (j == i && fr > tl_) v = 0.f;
                At[(16 * i + tl_) * 72 + 16 * j + fr] = f2bf(v); }
        }
        __syncthreads();
        f32x4 acc[4];
#pragma unroll
        for (int n = 0; n < 4; ++n) acc[n] = (f32x4){0.f, 0.f, 0.f, 0.f};
#pragma unroll
        for (int ks = 0; ks < 4; ++ks) {
            const bf16x8 qf = *(const bf16x8*)(Qe + (16 * mt + fr) * 136 + ks * 32 + fq * 8);
#pragma unroll
            for (int n = 0; n < 4; ++n) { const bf16x8 sf = *(const bf16x8*)(Sb + (16 * (ntb + n) + fr) * 136 + ks * 32 + fq * 8); acc[n] = mfma16(sf, qf, acc[n]); }
        }
#pragma unroll
        for (int ks = 0; ks < 2; ++ks) {
            const bf16x8 af = *(const bf16x8*)(At + (16 * mt + fr) * 72 + ks * 32 + fq * 8);
#pragma unroll
            for (int n = 0; n < 4; ++n) { const bf16x8 vf = *(const bf16x8*)(vT + (16 * (ntb + n) + fr) * 72 + ks * 32 + fq * 8); acc[n] = mfma16(vf, af, acc[n]); }
        }
        {
            float sq = 0.f;
#pragma unroll
            for (int n = 0; n < 4; ++n) sq += acc[n][0] * acc[n][0] + acc[n][1] * acc[n][1] + acc[n][2] * acc[n][2] + acc[n][3] * acc[n][3];
            sq += __shfl_xor(sq, 16); sq += __shfl_xor(sq, 32);
            if (fq == 0) ssq[(wid & 1) * 64 + 16 * mt + fr] = sq;
        }
        __syncthreads();
        {
            const int t = 16 * mt + fr;
            const float rs = rsqrtf((ssq[t] + ssq[64 + t]) * (1.0f / 128.0f) + 1e-6f);
            const size_t row = rowc + t;
#pragma unroll
            for (int n = 0; n < 4; ++n) {
                const u32x2 aw = agr[n];
                const float a0 = __uint_as_float(aw[0] << 16), a1 = __uint_as_float(aw[0] & 0xffff0000u), a2 = __uint_as_float(aw[1] << 16), a3 = __uint_as_float(aw[1] & 0xffff0000u);
                const f32x4 gq = ng4[n];
                u32x2 o; o[0] = pk2(acc[n][0] * rs * gq[0] * silu_f(a0), acc[n][1] * rs * gq[1] * silu_f(a1));
                o[1] = pk2(acc[n][2] * rs * gq[2] * silu_f(a2), acc[n][3] * rs * gq[3] * silu_f(a3));
                *(u32x2*)(p.h + row * 1024 + hh * 128 + 16 * (ntb + n) + 4 * fq) = o;
            }
        }
        __syncthreads();
    }
}

__device__ __forceinline__ void phase_attn(const Params& p, int e, unsigned char* smem) {
    const int tid = otid(), lane = tid & 63, wid = tid >> 6, fr = lane & 15, fq = lane >> 4;
    bf16_t* Ks = (bf16_t*)smem;
    bf16_t* VT = Ks + 256 * 72;
    bf16_t* Qs = VT + 64 * 264;
    bf16_t* P = Qs + 128 * 72;
    const int gstep = ogrid();
    u32x4 kv[4], vv[4], qv[2]; f32x4 krp[4], qrp[4];
    const int key = tid >> 1, dh = (tid & 1) * 32;
    const int qrow = tid >> 2, dq = (tid & 3) * 16;
    auto load_kv = [&](int item) {
        const int hk = item & 1, n = (item >> 1) & 15, b = item >> 5;
        const int row = b * 2048 + n * 128 - 128 + key;
        if ((n > 0) || (key >= 128)) {
            const bf16_t* kp = p.za + (size_t)row * ZW + 2560 + hk * 64 + dh;
#pragma unroll
            for (int i = 0; i < 4; ++i) { kv[i] = *(const u32x4*)(kp + 8 * i); vv[i] = *(const u32x4*)(kp + 128 + 8 * i); }
            if (dh == 0) {
#pragma unroll
                for (int i = 0; i < 4; ++i) krp[i] = *(const f32x4*)(p.rope + (size_t)row * 16 + 4 * i);
            }
        } else {
#pragma unroll
            for (int i = 0; i < 4; ++i) { kv[i] = (u32x4){0u, 0u, 0u, 0u}; vv[i] = (u32x4){0u, 0u, 0u, 0u}; krp[i] = (f32x4){1.f, 1.f, 1.f, 1.f}; }
        }
    };
    auto load_q = [&](int item, int g) {
        const int hk = item & 1, n = (item >> 1) & 15, b = item >> 5;
        const int row = b * 2048 + n * 128 + qrow;
        const bf16_t* qp = p.za + (size_t)row * ZW + 2048 + (hk * 4 + g) * 64 + dq;
        qv[0] = *(const u32x4*)qp; qv[1] = *(const u32x4*)(qp + 8);
        if (dq == 0) {
#pragma unroll
            for (int i = 0; i < 4; ++i) qrp[i] = *(const f32x4*)(p.rope + (size_t)row * 16 + 4 * i);
        }
    };
    if (obid() < 512) { load_kv(obid()); load_q(obid(), 0); }
    for (int item = obid(); item < 512; item += gstep) {
        const int hk = item & 1, n = (item >> 1) & 15, b = item >> 5;
        const int tok0 = b * 2048 + n * 128;
        {
            if (dh == 0) {
#pragma unroll
                for (int i = 0; i < 8; ++i) {
                    const unsigned w1 = kv[0][i >> 1], w2 = kv[1][i >> 1];
                    const float x1 = (i & 1) ? __uint_as_float(w1 & 0xffff0000u) : __uint_as_float(w1 << 16);
                    const float x2 = (i & 1) ? __uint_as_float(w2 & 0xffff0000u) : __uint_as_float(w2 << 16);
                    const float cs = krp[i >> 2][i & 3], sn = krp[2 + (i >> 2)][i & 3];
                    const unsigned r1 = f2bf(x1 * cs - x2 * sn), r2 = f2bf(x2 * cs + x1 * sn);
                    if (i & 1) { kv[0][i >> 1] = (kv[0][i >> 1] & 0xffffu) | (r1 << 16); kv[1][i >> 1] = (kv[1][i >> 1] & 0xffffu) | (r2 << 16); }
                    else { kv[0][i >> 1] = (kv[0][i >> 1] & 0xffff0000u) | r1; kv[1][i >> 1] = (kv[1][i >> 1] & 0xffff0000u) | r2; }
                }
            }
#pragma unroll
            for (int i = 0; i < 4; ++i) *(u32x4*)(Ks + key * 72 + dh + 8 * i) = kv[i];
#pragma unroll
            for (int i = 0; i < 4; ++i)
#pragma unroll
                for (int q = 0; q < 4; ++q) { const unsigned w = vv[i][q]; const int d = dh + 8 * i + 2 * q;
                    VT[d * 264 + key] = (bf16_t)(w & 0xffffu); VT[(d + 1) * 264 + key] = (bf16_t)(w >> 16); }
            if (item + gstep < 512) load_kv(item + gstep);
        }
        for (int g = 0; g < 4; ++g) {
            const int qh = hk * 4 + g;
            {
                float xf[16];
#pragma unroll
                for (int i = 0; i < 8; ++i) { xf[i] = ((i & 1) ? __uint_as_float(qv[0][i >> 1] & 0xffff0000u) : __uint_as_float(qv[0][i >> 1] << 16));
                    xf[8 + i] = ((i & 1) ? __uint_as_float(qv[1][i >> 1] & 0xffff0000u) : __uint_as_float(qv[1][i >> 1] << 16)); }
                if (dq == 0) {
#pragma unroll
                    for (int i = 0; i < 8; ++i) { const float cs = qrp[i >> 2][i & 3], sn = qrp[2 + (i >> 2)][i & 3], x1 = xf[i], x2 = xf[8 + i]; xf[i] = x1 * cs - x2 * sn; xf[8 + i] = x2 * cs + x1 * sn; }
                }
                u32x4 o0, o1;
#pragma unroll
                for (int i = 0; i < 4; ++i) { o0[i] = pk2(xf[2 * i] * 0.125f, xf[2 * i + 1] * 0.125f); o1[i] = pk2(xf[8 + 2 * i] * 0.125f, xf[8 + 2 * i + 1] * 0.125f); }
                *(u32x4*)(Qs + qrow * 72 + dq) = o0; *(u32x4*)(Qs + qrow * 72 + dq + 8) = o1;
                if (g < 3) load_q(item, g + 1); else if (item + gstep < 512) load_q(item + gstep, 0);
            }
            __syncthreads();
            const int nt0 = 2 * (wid >> 1);
            f32x4 sacc[10];
#pragma unroll
            for (int i = 0; i < 10; ++i) sacc[i] = (f32x4){0.f, 0.f, 0.f, 0.f};
#pragma unroll
            for (int ks = 0; ks < 2; ++ks) {
                const bf16x8 qf = *(const bf16x8*)(Qs + (16 * wid + fr) * 72 + ks * 32 + fq * 8);
#pragma unroll
                for (int i = 0; i < 10; ++i) { const bf16x8 kf = *(const bf16x8*)(Ks + (16 * (nt0 + i) + fr) * 72 + ks * 32 + fq * 8); sacc[i] = mfma16(kf, qf, sacc[i]); }
            }
            {
                const float sink = p.sinks[e * 8 + qh];
                const int ql = 16 * wid + fr;
                float mx = -1e30f;
#pragma unroll
                for (int i = 0; i < 10; ++i)
#pragma unroll
                    for (int j = 0; j < 4; ++j) { const int key = 16 * (nt0 + i) + 4 * fq + j, rel = 128 + ql - key;
                        const bool ok = (rel >= 0) && (rel < 128) && ((n > 0) || (key >= 128));
                        const float sv = ok ? sacc[i][j] : -1e30f; sacc[i][j] = sv; mx = fmaxf(mx, sv); }
                mx = fmaxf(mx, __shfl_xor(mx, 16)); mx = fmaxf(mx, __shfl_xor(mx, 32));
                mx = fmaxf(mx, sink);
                float sum = 0.f;
#pragma unroll
                for (int i = 0; i < 10; ++i)
#pragma unroll
                    for (int j = 0; j < 4; ++j) { const float pv = (sacc[i][j] > -1e29f) ? __expf(sacc[i][j] - mx) : 0.f; sacc[i][j] = pv; sum += pv; }
                sum += __shfl_xor(sum, 16); sum += __shfl_xor(sum, 32);
                const float inv = 1.0f / (sum + __expf(sink - mx));
#pragma unroll
                for (int i = 0; i < 10; ++i) { u32x2 o; o[0] = pk2(sacc[i][0] * inv, sacc[i][1] * inv); o[1] = pk2(sacc[i][2] * inv, sacc[i][3] * inv);
                    *(u32x2*)(P + ql * 264 + 16 * (nt0 + i) + 4 * fq) = o; }
            }
            __syncthreads();
            f32x4 oacc[4];
#pragma unroll
            for (int mt2 = 0; mt2 < 4; ++mt2) oacc[mt2] = (f32x4){0.f, 0.f, 0.f, 0.f};
#pragma unroll
            for (int s5 = 0; s5 < 5; ++s5) {
                const int ks = (wid >> 1) + s5;
                const bf16x8 pf = *(const bf16x8*)(P + (16 * wid + fr) * 264 + ks * 32 + fq * 8);
#pragma unroll
                for (int mt2 = 0; mt2 < 4; ++mt2) { const bf16x8 vf = *(const bf16x8*)(VT + (16 * mt2 + fr) * 264 + ks * 32 + fq * 8); oacc[mt2] = mfma16(vf, pf, oacc[mt2]); }
            }
#pragma unroll
            for (int mt2 = 0; mt2 < 4; ++mt2) { u32x2 o; o[0] = pk2(oacc[mt2][0], oacc[mt2][1]); o[1] = pk2(oacc[mt2][2], oacc[mt2][3]);
                *(u32x2*)(p.h + (size_t)(tok0 + 16 * wid + fr) * 1024 + 512 + qh * 64 + 16 * mt2 + 4 * fq) = o; }
            __syncthreads();
        }
    }
}

template <int W> __device__ __forceinline__ void pool_task(const Params& p, int g, int row, int c8) {
    const int t = row & 2047, col = g * 256 + c8;
    u32x4 v[W];
#pragma unroll
    for (int j = 0; j < W; ++j) { const int rj = (j <= t) ? row - j : row; v[j] = *(const u32x4*)(p.h + (size_t)rj * 1024 + col); }
    float s[8];
#pragma unroll
    for (int e = 0; e < 8; ++e) s[e] = 0.f;
#pragma unroll
    for (int j = 0; j < W; ++j) {
        const float wgt = (j <= t) ? 1.0f : 0.0f;
#pragma unroll
        for (int q = 0; q < 4; ++q) { s[2 * q] += wgt * __uint_as_float(v[j][q] << 16); s[2 * q + 1] += wgt * __uint_as_float(v[j][q] & 0xffff0000u); }
    }
    const int cnt = (t + 1 < W) ? (t + 1) : W;
    const float ic = 1.0f / (float)cnt;
    u32x4 o;
#pragma unroll
    for (int q = 0; q < 4; ++q) o[q] = pk2(s[2 * q] * ic - __uint_as_float(v[0][q] << 16), s[2 * q + 1] * ic - __uint_as_float(v[0][q] & 0xffff0000u));
    *(u32x4*)(p.za + ((size_t)g * MTOK + row) * 256 + c8) = o;
}
__device__ __forceinline__ void phase_pool(const Params& p) {
    for (int T = obid() * 512 + otid(); T < 4 * MTOK * 32; T += ogrid() * 512) {
        const int g = T >> 20, row = (T >> 5) & (MTOK - 1), c8 = (T & 31) * 8;
        if (g == 0) pool_task<2>(p, g, row, c8);
        else if (g == 1) pool_task<4>(p, g, row, c8);
        else if (g == 2) pool_task<8>(p, g, row, c8);
        else pool_task<16>(p, g, row, c8);
    }
}


template <int W> __device__ __forceinline__ void poolmix_quad(const Params& p, bf16_t* PT, int g, int r0, int R0, int c8) {
    const int col = g * 256 + c8, t0 = (R0 & 2047) + r0 - (W - 1);
    const bf16_t* base = p.h + (size_t)(R0 + r0 - (W - 1)) * 1024 + col;
    u32x4 v[W + 3];
#pragma unroll
    for (int i = 0; i < W + 3; ++i) { const int ii = (t0 + i >= 0) ? i : (W - 1); v[i] = *(const u32x4*)(base + (ptrdiff_t)ii * 1024); }
    float s[8];
#pragma unroll
    for (int e = 0; e < 8; ++e) s[e] = 0.f;
#pragma unroll
    for (int i = 0; i < W; ++i) {
        const float wgt = (t0 + i >= 0) ? 1.0f : 0.0f;
#pragma unroll
        for (int q = 0; q < 4; ++q) { s[2 * q] += wgt * __uint_as_float(v[i][q] << 16); s[2 * q + 1] += wgt * __uint_as_float(v[i][q] & 0xffff0000u); }
    }
#pragma unroll
    for (int qr = 0; qr < 4; ++qr) {
        if (qr > 0) {
            const float wo = (t0 + qr - 1 >= 0) ? 1.0f : 0.0f;
#pragma unroll
            for (int q = 0; q < 4; ++q) {
                s[2 * q] += __uint_as_float(v[qr + W - 1][q] << 16) - wo * __uint_as_float(v[qr - 1][q] << 16);
                s[2 * q + 1] += __uint_as_float(v[qr + W - 1][q] & 0xffff0000u) - wo * __uint_as_float(v[qr - 1][q] & 0xffff0000u);
            }
        }
        const int t = t0 + W - 1 + qr, cnt = (t + 1 < W) ? (t + 1) : W;
        const float ic = 1.0f / (float)cnt;
        u32x4 o;
#pragma unroll
        for (int q = 0; q < 4; ++q) o[q] = pk2(s[2 * q] * ic - __uint_as_float(v[qr + W - 1][q] << 16), s[2 * q + 1] * ic - __uint_as_float(v[qr + W - 1][q] & 0xffff0000u));
        *(u32x4*)(PT + (r0 + qr) * 1032 + col) = o;
    }
}
template <int W> __device__ __forceinline__ void poolmix_task(const Params& p, bf16_t* PT, int g, int r, int row, int c8) {
    const int t = row & 2047, col = g * 256 + c8;
    u32x4 v[W];
#pragma unroll
    for (int j = 0; j < W; ++j) { const int rj = (j <= t) ? row - j : row; v[j] = *(const u32x4*)(p.h + (size_t)rj * 1024 + col); }
    float s[8];
#pragma unroll
    for (int e = 0; e < 8; ++e) s[e] = 0.f;
#pragma unroll
    for (int j = 0; j < W; ++j) {
        const float wgt = (j <= t) ? 1.0f : 0.0f;
#pragma unroll
        for (int q = 0; q < 4; ++q) { s[2 * q] += wgt * __uint_as_float(v[j][q] << 16); s[2 * q + 1] += wgt * __uint_as_float(v[j][q] & 0xffff0000u); }
    }
    const int cnt = (t + 1 < W) ? (t + 1) : W;
    const float ic = 1.0f / (float)cnt;
    u32x4 o;
#pragma unroll
    for (int q = 0; q < 4; ++q) o[q] = pk2(s[2 * q] * ic - __uint_as_float(v[0][q] << 16), s[2 * q + 1] * ic - __uint_as_float(v[0][q] & 0xffff0000u));
    *(u32x4*)(PT + r * 1032 + col) = o;
}
__device__ __forceinline__ void phase_poolmix(const Params& p, int l, unsigned char* smem) {
    typedef float f32x2v __attribute__((ext_vector_type(2)));
    const int tid = otid(), lane = tid & 63, wid = __builtin_amdgcn_readfirstlane(tid >> 6);
    bf16_t* PT = (bf16_t*)smem;
    f32x2v* Pst = (f32x2v*)(smem + 132096);
    f32x2v* Sst = (f32x2v*)(smem + 132096 + 4096);
    const int g = wid >> 1, cbase = g * 256 + (wid & 1) * 128;
    const bf16_t* Wt = p.wt_pool + (size_t)(l >> 1) * 4 * 65536 + (size_t)g * 65536 + (size_t)(wid & 1) * 8 * 4096;
    bf16_t* hdst = (bf16_t*)p.L;
    const float* lng = p.ln_g + (l * 2) * 1024; const float* lnb = p.ln_b + (l * 2) * 1024;
    for (int item = obid(); item < 512; item += ogrid()) {
        const int R0 = item * 64, b = R0 >> 11;
        int lane_o = lane; asm volatile("" : "+v"(lane_o));
        const int fr = lane_o & 15, fq = lane_o >> 4;
        {
            const int r0 = (tid >> 5) * 4, c8 = (tid & 31) * 8;
            poolmix_quad<2>(p, PT, 0, r0, R0, c8);
            poolmix_quad<4>(p, PT, 1, r0, R0, c8);
            poolmix_quad<8>(p, PT, 2, r0, R0, c8);
            poolmix_quad<16>(p, PT, 3, r0, R0, c8);
        }
        __syncthreads();
#pragma clang loop unroll(disable)
        for (int rh = 0; rh < 2; ++rh) {
            f32x4 acc[2][8];
#pragma unroll
            for (int mt = 0; mt < 2; ++mt)
#pragma unroll
                for (int nt = 0; nt < 8; ++nt) acc[mt][nt] = (f32x4){0.f, 0.f, 0.f, 0.f};
            const bf16_t* wb0 = Wt + (size_t)(fq * 16 + fr) * 8;
            asm volatile("" : "+v"(wb0));
            const __attribute__((address_space(1))) bf16_t* wb = (const __attribute__((address_space(1))) bf16_t*)wb0;
            const bf16_t* pb = PT + (32 * rh + fr) * 1032 + g * 256 + fq * 8;
            bf16x8 wf[8];
#pragma unroll
            for (int nt = 0; nt < 8; ++nt) wf[nt] = *(const __attribute__((address_space(1))) bf16x8*)(wb + nt * 4096);
#pragma unroll
            for (int ks = 0; ks < 8; ++ks) {
                bf16x8 wn[8];
                if (ks < 7) {
#pragma unroll
                    for (int nt = 0; nt < 8; ++nt) wn[nt] = *(const __attribute__((address_space(1))) bf16x8*)(wb + nt * 4096 + (ks + 1) * 512);
                }
                bf16x8 pf[2];
#pragma unroll
                for (int mt = 0; mt < 2; ++mt) pf[mt] = *(const bf16x8*)(pb + mt * 16 * 1032 + ks * 32);
#pragma unroll
                for (int nt = 0; nt < 8; ++nt)
#pragma unroll
                    for (int mt = 0; mt < 2; ++mt) acc[mt][nt] = mfma16(wf[nt], pf[mt], acc[mt][nt]);
                if (ks < 7) {
#pragma unroll
                    for (int nt = 0; nt < 8; ++nt) wf[nt] = wn[nt];
                }
            }
            {
                const float* gp = p.mod + ((size_t)l * 16 + b) * 6144 + 2048 + cbase + 4 * fq;
                f32x4 gv[8];
#pragma unroll
                for (int nt = 0; nt < 8; ++nt) gv[nt] = *(const f32x4*)(gp + 16 * nt);
                f32x4 xi[2][8];
#pragma unroll
                for (int mt = 0; mt < 2; ++mt) {
                    const float* xr = p.out + (size_t)(R0 + 32 * rh + 16 * mt + fr) * 1024 + cbase + 4 * fq;
#pragma unroll
                    for (int nt = 0; nt < 8; ++nt) xi[mt][nt] = *(const f32x4*)(xr + 16 * nt);
                }
#pragma unroll
                for (int mt = 0; mt < 2; ++mt) {
                    float sm = 0.f;
#pragma unroll
                    for (int nt = 0; nt < 8; ++nt) { const f32x4 v = xi[mt][nt] * ALPHA_C + gv[nt] * acc[mt][nt]; acc[mt][nt] = v; sm += (v[0] + v[1]) + (v[2] + v[3]); }
                    sm += __shfl_xor(sm, 16); sm += __shfl_xor(sm, 32);
                    const float mw = sm * (1.0f / 128.0f); float q = 0.f;
#pragma unroll
                    for (int nt = 0; nt < 8; ++nt) { const f32x4 d = acc[mt][nt] - mw; q += (d[0] * d[0] + d[1] * d[1]) + (d[2] * d[2] + d[3] * d[3]); }
                    q += __shfl_xor(q, 16); q += __shfl_xor(q, 32);
                    if (fq == 0) Pst[(16 * mt + fr) * 8 + wid] = (f32x2v){mw, q};
                }
            }
            __syncthreads();
            if (tid < 32) {
                float mt8[8], m28[8]; float ms = 0.f;
#pragma unroll
                for (int w = 0; w < 8; ++w) { const f32x2v a = Pst[tid * 8 + w]; mt8[w] = a.x; m28[w] = a.y; ms += a.x; }
                const float mean = ms * 0.125f; float q = 0.f;
#pragma unroll
                for (int w = 0; w < 8; ++w) { const float dm = mt8[w] - mean; q += m28[w] + 128.0f * dm * dm; }
                Sst[tid] = (f32x2v){mean, 1.0f / sqrtf(q * (1.0f / 1024.0f) + 1e-5f)};
            }
            __syncthreads();
            {
                const float* mp = p.mod + ((size_t)l * 16 + b) * 6144 + cbase + 4 * fq;
#pragma unroll
                for (int nt = 0; nt < 8; ++nt) {
                    const int co = cbase + 16 * nt + 4 * fq;
                    const f32x4 gg = *(const f32x4*)(lng + co), bb = *(const f32x4*)(lnb + co);
                    const f32x4 sc = *(const f32x4*)(mp + 4096 + 16 * nt), sh = *(const f32x4*)(mp + 3072 + 16 * nt);
#pragma unroll
                    for (int mt = 0; mt < 2; ++mt) {
                        const int r = 16 * mt + fr; const f32x2v sr = Sst[r];
                        const size_t off = (size_t)(R0 + 32 * rh + r) * 1024 + co;
                        const f32x4 y = (acc[mt][nt] - sr.x) * sr.y * gg + bb;
                        *(f32x4*)(p.out + off) = y;
                        const f32x4 hh = y * (sc + 1.0f) + sh;
                        u32x2 o; o[0] = pk2(hh[0], hh[1]); o[1] = pk2(hh[2], hh[3]);
                        *(u32x2*)(hdst + off) = o;
                    }
                }
            }
        }
        __syncthreads();
    }
}

__device__ __forceinline__ void phase_fixup(const Params& p, int l) {
    const float* cw = p.conv_w + (size_t)l * 3 * FF; const float* cb = p.conv_b + (size_t)l * FF;
    for (int task = obid() * 512 + otid(); task < 512 * 704; task += ogrid() * 512) {
        const int s = task / 704, f = (task % 704) * 4;
        const float* sd = p.side + (size_t)s * (6 * FF) + f;
        const f32x4 u0 = *(const f32x4*)(sd), u1 = *(const f32x4*)(sd + FF), v0 = *(const f32x4*)(sd + 2 * FF), v1 = *(const f32x4*)(sd + 3 * FF);
        f32x4 um2 = (f32x4){0.f, 0.f, 0.f, 0.f}, um1 = um2;
        if ((s & 31) != 0) { const float* sp = sd - 6 * FF; um2 = *(const f32x4*)(sp + 4 * FF); um1 = *(const f32x4*)(sp + 5 * FF); }
        const f32x4 w0 = *(const f32x4*)(cw + f), w1 = *(const f32x4*)(cw + FF + f), w2 = *(const f32x4*)(cw + 2 * FF + f), bb = *(const f32x4*)(cb + f);
        const f32x4 c0 = bb + w0 * um2 + w1 * um1 + w2 * u0, c1 = bb + w0 * um1 + w1 * u0 + w2 * u1;
        f32x4 r0, r1;
#pragma unroll
        for (int e = 0; e < 4; ++e) { r0[e] = silu_f(c0[e]) * v0[e]; r1[e] = silu_f(c1[e]) * v1[e]; }
        u32x2 o0, o1; o0[0] = pk2(r0[0], r0[1]); o0[1] = pk2(r0[2], r0[3]); o1[0] = pk2(r1[0], r1[1]); o1[1] = pk2(r1[2], r1[3]);
        *(u32x2*)(p.za + (size_t)(64 * s) * FF + f) = o0;
        *(u32x2*)(p.za + (size_t)(64 * s + 1) * FF + f) = o1;
    }
}

__device__ __forceinline__ void gemm_in(const Params& p, int e, LAS unsigned char* lds) {
    pg8::StaticOrder S; S.init(MTOK, ZW, ogrid(), obid());
    pg8::Gemm g{p.h, p.wt_in + (size_t)e * ZW * 1024, MTOK, ZW, 1024};
    EpiStoreBf16 E{p.za, ZW};
    pg8::gemm_phase(lds, g, S, E);
}
__device__ __forceinline__ LnFuse make_lnfuse(const Params& p, int l, int sub) {
    LnFuse f;
    f.xin = (l == 0 && sub == 0) ? p.x_in : p.out; f.xout = p.out;
    f.gate = p.mod + (size_t)l * 16 * 6144 + (sub == 0 ? 2048 : 5120);
    f.lng = p.ln_g + (l * 2 + sub) * 1024; f.lnb = p.ln_b + (l * 2 + sub) * 1024;
    const bool last = (l == 3 && sub == 1);
    const int nl = sub == 0 ? l : l + 1;
    f.msc = last ? nullptr : p.mod + (size_t)nl * 16 * 6144 + (sub == 0 ? 4096 : 1024);
    f.msh = last ? nullptr : p.mod + (size_t)nl * 16 * 6144 + (sub == 0 ? 3072 : 0);
    f.hout = p.h;
    f.xbuf = (unsigned long long*)p.xbuf; f.cnt = p.bar + XCD_BAR_WORDS; f.tmo = p.bar + XB_TMO; f.want = 32u * (unsigned)((l >> 1) * 3 + ((l & 1) ? 3 : (sub + 1)));
    return f;
}
__device__ __forceinline__ void gemm_out(const Params& p, int l, LAS unsigned char* lds) {
    pg8::Gemm g{p.h, p.wt_out + (size_t)(l >> 1) * 1024 * 1024, MTOK, 1024, 1024};
    EpiResidLn<false> E{make_lnfuse(p, l, 0)};
#pragma clang loop unroll(disable)
    for (int pass = 0; pass < 2; ++pass) {
        pg8::PassOrder S; S.S.init(MTOK, 1024, ogrid(), obid()); S.pass = pass;
        pg8::gemm_phase(lds, g, S, E);
    }
}
__device__ __forceinline__ void gemm_pool(const Params& p, int l, LAS unsigned char* lds) {
    int kdim = 256; asm volatile("" : "+s"(kdim));
    pg8::Gemm g{p.za, p.wt_pool + (size_t)(l >> 1) * 4 * 65536, 4 * MTOK, 256, kdim};
    EpiResidLn<true> E{make_lnfuse(p, l, 0)};
#pragma clang loop unroll(disable)
    for (int pass = 0; pass < 2; ++pass) {
        pg8::PoolPassOrder S{ogrid(), obid(), pass};
        pg8::gemm_phase(lds, g, S, E);
    }
}
__device__ __forceinline__ void gemm_up(const Params& p, int l, LAS unsigned char* lds) {
    pg8::StaticOrder S; S.init(MTOK, 2 * FF, ogrid(), obid());
    pg8::Gemm g{(l & 1) ? (const bf16_t*)p.L : (const bf16_t*)p.h, p.wt_up + (size_t)l * 2 * FF * 1024, MTOK, 2 * FF, 1024};
    EpiConvGate E{p.za, p.side, p.conv_w + (size_t)l * 3 * FF, p.conv_b + (size_t)l * FF};
    pg8::gemm_phase(lds, g, S, E);
}
__device__ __forceinline__ void gemm_down(const Params& p, int l, LAS unsigned char* lds) {
    pg8::Gemm g{p.za, p.wt_down + (size_t)l * 1024 * FF, MTOK, 1024, FF};
    EpiResidLn<false> E{make_lnfuse(p, l, 1)};
#pragma clang loop unroll(disable)
    for (int pass = 0; pass < 2; ++pass) {
        pg8::PassOrder S; S.S.init(MTOK, 1024, ogrid(), obid()); S.pass = pass;
        pg8::gemm_phase(lds, g, S, E);
    }
}

enum { PH_PREP = 0, PH_H0, PH_GEMM_IN, PH_MIX1, PH_HGRNB, PH_HGRNC, PH_GEMM_OUT, PH_POOL, PH_GEMM_POOL, PH_LN0, PH_GEMM_UP, PH_FIXUP, PH_GEMM_DOWN, PH_LN1 };

__device__ __forceinline__ void run_phase(const Params& p, int ph, int l, unsigned char* smem) {
    LAS unsigned char* lds = (LAS unsigned char*)smem;
    switch (ph) {
        case PH_PREP: phase_prep(p, smem); break;
        case PH_H0: phase_h0(p); break;
        case PH_GEMM_IN: gemm_in(p, l >> 1, lds); break;
        case PH_MIX1: phase_hgrnA(p, l >> 1, smem); break;
        case PH_HGRNB: if (obid() & 8) { phase_hgrnB(p); __syncthreads(); phase_attn(p, l >> 1, smem); } else { phase_attn(p, l >> 1, smem); phase_hgrnB(p); } break;
        case PH_HGRNC: phase_hgrnC(p, l >> 1, smem); break;
        case PH_GEMM_OUT: gemm_out(p, l, lds); break;
        case PH_POOL: phase_poolmix(p, l, smem); break;
        case PH_GEMM_UP: gemm_up(p, l, lds); break;
        case PH_FIXUP: phase_fixup(p, l); break;
        case PH_GEMM_DOWN: gemm_down(p, l, lds); break;
    }
}


#define XB_XCNT(j)  (256  + 64 * (j))
#define XB_XSUB(j)  (1280 + 64 * (j))
#define XB_XGEN(j)  (2304 + 64 * (j))
#define XB_TOP      3328
#define XB_TOPGEN   3392
#define XB_SPIN_CAP (1u << 18)
__device__ __forceinline__ unsigned xb_ld(unsigned* p)              { return __hip_atomic_load(p, __ATOMIC_RELAXED, __HIP_MEMORY_SCOPE_AGENT); }
__device__ __forceinline__ unsigned xb_add(unsigned* p, unsigned v) { return __hip_atomic_fetch_add(p, v, __ATOMIC_RELAXED, __HIP_MEMORY_SCOPE_AGENT); }
__device__ __forceinline__ unsigned xb_xcc_id() { return (unsigned)__builtin_amdgcn_s_getreg((3 << 11) | 20) & 0xFu; }
#define XB_SPIN(cond, bar) do { unsigned _sp = 0; while (cond) { __builtin_amdgcn_s_sleep(1); \
    if ((++_sp & 255u) == 0u) { if (xb_ld(&(bar)[XB_TMO])) break; if (_sp > XB_SPIN_CAP) { atomicAdd(&(bar)[XB_TMO], 1u); break; } } } } while (0)
struct XcdBarrier { unsigned* bar; unsigned x; volatile LAS unsigned* st; };
__device__ __forceinline__ XcdBarrier xcd_barrier_post(unsigned* bar, volatile LAS unsigned* st) {
    XcdBarrier b; b.bar = bar; b.x = xb_xcc_id(); b.st = st;
    if (threadIdx.x == 0) (void)xb_add(&bar[XB_XCNT(b.x)], 1u);
    return b;
}
__device__ __forceinline__ void xcd_barrier_complete(unsigned* bar, unsigned x, unsigned& nloc, unsigned& nx) {
    const unsigned G = gridDim.x * gridDim.y * gridDim.z;
    unsigned sum, cnt, mine, sp = 0u;
    for (;;) {
        sum = 0u; cnt = 0u; mine = 0u;
#pragma unroll
        for (unsigned j = 0; j < 16; ++j) { const unsigned c = xb_ld(&bar[XB_XCNT(j)]); sum += c; cnt += (c > 0u) ? 1u : 0u; mine = (j == x) ? c : mine; }
        if (sum == G) break;
        __builtin_amdgcn_s_sleep(1);
        if ((++sp & 255u) == 0u) { if (xb_ld(&bar[XB_TMO])) break; if (sp > XB_SPIN_CAP) { atomicAdd(&bar[XB_TMO], 1u); break; } }
    }
    nloc = mine > 0u ? mine : 1u; nx = cnt > 0u ? cnt : 1u;
}
__device__ __forceinline__ void xcd_barrier(const XcdBarrier& b) {
    asm volatile("s_waitcnt vmcnt(0)" ::: "memory");
    __syncthreads();
    if (threadIdx.x == 0) {
        unsigned* bar = b.bar;
        __builtin_amdgcn_s_waitcnt(0);
        unsigned nloc = b.st[0], nx = b.st[1];
        if (nloc == 0u) { xcd_barrier_complete(bar, b.x, nloc, nx); b.st[0] = nloc; b.st[1] = nx; }
        const unsigned old = xb_add(&bar[XB_XSUB(b.x)], 1u);
        const unsigned gen = old / nloc;
        if (old + 1u == (gen + 1u) * nloc) {
            __builtin_amdgcn_fence(__ATOMIC_RELEASE, "agent");
            asm volatile("s_waitcnt vmcnt(0)" ::: "memory");
            const unsigned og = xb_add(&bar[XB_TOP], 1u);
            const unsigned tg = og / nx;
            if (og + 1u == (tg + 1u) * nx) xb_add(&bar[XB_TOPGEN], 1u);
            else XB_SPIN(xb_ld(&bar[XB_TOPGEN]) == tg, bar);
            __builtin_amdgcn_fence(__ATOMIC_ACQUIRE, "agent");
            xb_add(&bar[XB_XGEN(b.x)], 1u);
            asm volatile("s_waitcnt vmcnt(0)" ::: "memory");
        } else {
            XB_SPIN(xb_ld(&bar[XB_XGEN(b.x)]) == gen, bar);
            __builtin_amdgcn_fence(__ATOMIC_ACQUIRE, "agent");
            asm volatile("s_waitcnt vmcnt(0)" ::: "memory");
        }
    }
    __syncthreads();
}

__device__ __forceinline__ void decode_step(int step, int& ph, int& l) {
    if (step < 2) { ph = step; l = 0; return; }
    const int s2 = step - 2, pair = s2 / 12, r = s2 % 12;
    const unsigned long long tbl = 0x2ull | (0x3ull << 4) | (0x4ull << 8) | (0x5ull << 12) | (0x6ull << 16) | (0xAull << 20) | (0xBull << 24) | (0xCull << 28)
                                 | (0x7ull << 32) | (0xAull << 36) | (0xBull << 40) | (0xCull << 44);
    ph = (int)((tbl >> (4 * r)) & 15ull);
    l = 2 * pair + (r >= 8 ? 1 : 0);
}
constexpr int NSTEPS = 26;
#if MEGA
__global__ void __launch_bounds__(512, 2) fwd_mega(Params p) {
    extern __shared__ __attribute__((aligned(16))) unsigned char smem[];
    cg::grid_group grid = cg::this_grid();
    volatile LAS unsigned* st = (volatile LAS unsigned*)((LAS unsigned char*)smem + (LDS_BYTES - 16));
    if (threadIdx.x == 0) { st[0] = 0u; st[1] = 0u; }
    __syncthreads();
    const XcdBarrier xb = xcd_barrier_post(p.bar, st);
#pragma clang loop unroll(disable)
    for (int step = 0; step < NSTEPS; ++step) {
        int ph, l; decode_step(step, ph, l);
        run_phase(p, ph, l, smem);
#ifdef PROBE_MASK
        if ((PROBE_MASK >> ph) & 1) { xcd_barrier(xb); run_phase(p, ph, l, smem); }
#endif
        if (p.bar == nullptr) grid.sync();
        if (step + 1 < NSTEPS) xcd_barrier(xb);
    }
}
#else
__global__ void __launch_bounds__(512, 2) fwd_phase(Params p, int step) {
    extern __shared__ __attribute__((aligned(16))) unsigned char smem[];
    int ph, l; decode_step(step, ph, l);
    run_phase(p, ph, l, smem);
}
#endif

extern "C" void kernel_launch(void* const* d_in, const int* in_sizes, int n_in, void* d_out, int out_size, void* d_ws, size_t ws_size, hipStream_t stream) {
    (void)in_sizes; (void)n_in; (void)out_size; (void)ws_size;
    Params p{};
    p.x_in = (const float*)d_in[0]; p.c = (const float*)d_in[1]; p.pos = (const int*)d_in[2]; p.ada_w = (const float*)d_in[3]; p.ada_b = (const float*)d_in[4];
    p.ln_g = (const float*)d_in[5]; p.ln_b = (const float*)d_in[6]; p.w_in = (const float*)d_in[7]; p.w_out = (const float*)d_in[8]; p.lb_raw = (const float*)d_in[9];
    p.norm_g = (const float*)d_in[10]; p.sinks = (const float*)d_in[11]; p.pool_w = (const float*)d_in[12]; p.pool_scale = (const float*)d_in[13];
    p.w_up = (const float*)d_in[14]; p.conv_w = (const float*)d_in[15]; p.conv_b = (const float*)d_in[16]; p.w_down = (const float*)d_in[17];
    p.out = (float*)d_out;
    char* w = (char*)d_ws; size_t off = 0;
    auto take = [&](size_t bytes) { char* r = w + off; off += (bytes + 255) & ~(size_t)255; return r; };
    p.wt_in = (bf16_t*)take((size_t)2 * ZW * 1024 * 2);
    p.wt_out = (bf16_t*)take((size_t)2 * 1024 * 1024 * 2);
    p.wt_up = (bf16_t*)take((size_t)4 * 2 * FF * 1024 * 2);
    p.wt_down = (bf16_t*)take((size_t)4 * 1024 * FF * 2);
    p.wt_pool = (bf16_t*)take((size_t)2 * 4 * 65536 * 2);
    p.mod = (float*)take((size_t)4 * 16 * 6144 * 4);
    p.rope = (float*)take((size_t)MTOK * 16 * 4);
    p.h = (bf16_t*)take((size_t)MTOK * 1024 * 2);
    p.za = (bf16_t*)take((size_t)MTOK * ZW * 2);
    p.L = (float*)take((size_t)2048 * 16384 * 4);
    p.dec = (float*)take((size_t)2048 * 128 * 4);
    p.side = (float*)take((size_t)512 * 6 * FF * 4);
    p.bar = (unsigned*)take((size_t)BAR_TOTAL_WORDS * 4);
    p.xbuf = (unsigned*)take((size_t)MTOK * 4 * 8);
#if MEGA
    static bool attr_set = false;
    if (!attr_set) { (void)hipFuncSetAttribute((const void*)fwd_mega, hipFuncAttributeMaxDynamicSharedMemorySize, LDS_BYTES); attr_set = true; }
    int dev = 0, cus = 0, per_cu = 0;
    (void)hipGetDevice(&dev);
    (void)hipDeviceGetAttribute(&cus, hipDeviceAttributeMultiprocessorCount, dev);
    (void)hipOccupancyMaxActiveBlocksPerMultiprocessor(&per_cu, fwd_mega, 512, LDS_BYTES);
    if (per_cu < 1) per_cu = 1;
    int grid = 256;
    (void)cus;
    (void)hipMemsetAsync(p.bar, 0, (size_t)BAR_TOTAL_WORDS * 4, stream);
    void* args[] = {&p};
    hipError_t err = hipLaunchCooperativeKernel((const void*)fwd_mega, dim3(grid), dim3(512), args, LDS_BYTES, stream);
    if (err != hipSuccess) fprintf(stderr, "cooperative launch failed: %s (grid %d)\n", hipGetErrorString(err), grid);
#else
    static bool attr_set = false;
    if (!attr_set) { (void)hipFuncSetAttribute((const void*)fwd_phase, hipFuncAttributeMaxDynamicSharedMemorySize, LDS_BYTES); attr_set = true; }
    for (int step = 0; step < NSTEPS; ++step) fwd_phase<<<256, 512, LDS_BYTES, stream>>>(p, step);
#endif
}
```
